# Optimizing an MI355X kernel written in HIP

```python
import math
import jax, jax.numpy as jnp
from jax import lax
import numpy as np

D_MODEL = 1024
BATCH = 32
SEQ = 2048
DEPTH = 1
DEC_BATCH = 8
DEC_SEQ = 2048
PAST_LEN = 128

ATTN_WIDTH = D_MODEL // 2
HYENA_WIDTH = D_MODEL - ATTN_WIDTH
HEAD_DIM = 64
N_HEADS = ATTN_WIDTH // HEAD_DIM
DILATED_BRANCHES = ((128, 1), (512, 4), (2048, 16))
ATTN_BLOCK = 64
ROPE_THETA = 10000.0
HYENA_ORDER = 2
SHORT_CONV = 3
FILTER_EMB = 33
FILTER_HIDDEN = 64
FILTER_OUT = HYENA_ORDER * 2 * HYENA_WIDTH
DECAY_TARGET = 1e-2
FAST_DECAY_PCT = 0.3
SLOW_DECAY_PCT = 1.5
D_FF = 4 * D_MODEL
IN_WIDTH = 3 * ATTN_WIDTH + 3 * HYENA_WIDTH
EPS = 1e-6
NEG_INF = -1e30

kernel_name = "hybrid_dilated_attn_hyena_encoder"


def rmsnorm(x, g):
    xf = x.astype(jnp.float32)
    y = xf * lax.rsqrt(jnp.mean(xf * xf, axis=-1, keepdims=True) + EPS) * g.astype(jnp.float32)
    return y.astype(x.dtype)


def rmsnorm_f32(x, g):
    return x * lax.rsqrt(jnp.mean(x * x, axis=-1, keepdims=True) + EPS) * g.astype(jnp.float32)


def rope(x):
    S, E = x.shape[1], x.shape[3]
    half = E // 2
    inv_freq = ROPE_THETA ** (-jnp.arange(half, dtype=jnp.float32) / half)
    ang = jnp.arange(S, dtype=jnp.float32)[:, None] * inv_freq[None, :]
    c = jnp.cos(ang)[None, :, None, :]
    s = jnp.sin(ang)[None, :, None, :]
    x1, x2 = x[..., :half], x[..., half:]
    return jnp.concatenate([x1 * c - x2 * s, x2 * c + x1 * s], axis=-1)


def window_attention(q, k, v, half):
    N, L, H, E = q.shape
    blk = ATTN_BLOCK
    nb = -(-L // blk)
    Lp = nb * blk
    W = blk + 2 * half
    qb = jnp.pad(q, ((0, 0), (0, Lp - L), (0, 0), (0, 0))).reshape(N, nb, blk, H, E)
    pad_kv = ((0, 0), (half, Lp - L + half), (0, 0), (0, 0))
    kp = jnp.pad(k, pad_kv)
    vp = jnp.pad(v, pad_kv)
    idx = (jnp.arange(nb) * blk)[:, None] + jnp.arange(W)[None, :]
    kb = kp[:, idx]
    vb = vp[:, idx]
    s = jnp.einsum('nbqhe,nbkhe->nbhqk', qb, kb) * (1.0 / math.sqrt(E))
    qpos = (jnp.arange(nb) * blk)[:, None] + jnp.arange(blk)[None, :]
    kpos = idx - half
    rel = kpos[:, None, :] - qpos[:, :, None]
    valid = (jnp.abs(rel) <= half) & (kpos >= 0)[:, None, :] & (kpos < L)[:, None, :]
    s = jnp.where(valid[None, :, None, :, :], s, NEG_INF)
    lse = jax.nn.logsumexp(s, axis=-1)
    p = jnp.exp(s - lse[..., None])
    out = jnp.einsum('nbhqk,nbkhe->nbqhe', p, vb).reshape(N, Lp, H, E)[:, :L]
    lse = lse.transpose(0, 1, 3, 2).reshape(N, Lp, H)[:, :L]
    return out, lse


def dilated_branch(q, k, v, window, dilation):
    B, S, H, E = q.shape
    L = S // dilation
    half = window // (2 * dilation)

    def to_res(t):
        return t.reshape(B, L, dilation, H, E).transpose(0, 2, 1, 3, 4).reshape(B * dilation, L, H, E)

    out, lse = window_attention(to_res(q), to_res(k), to_res(v), half)
    out = out.reshape(B, dilation, L, H, E).transpose(0, 2, 1, 3, 4).reshape(B, S, H, E)
    lse = lse.reshape(B, dilation, L, H).transpose(0, 2, 1, 3).reshape(B, S, H)
    return out, lse


def dilated_attention(q, k, v):
    outs, lses = [], []
    for window, dilation in DILATED_BRANCHES:
        o, l = dilated_branch(q, k, v, window, dilation)
        outs.append(o)
        lses.append(l)
    wts = jax.nn.softmax(jnp.stack(lses, axis=0), axis=0)
    return jnp.sum(wts[..., None] * jnp.stack(outs, axis=0), axis=0)


def short_conv(u, w, b):
    pad = SHORT_CONV // 2
    S = u.shape[1]
    up = jnp.pad(u, ((0, 0), (pad, SHORT_CONV - 1 - pad), (0, 0)))
    y = b
    for t in range(SHORT_CONV):
        y = y + up[:, t:t + S] * w[t]
    return y


def implicit_filter_spectra(L, w1, b1, f1, w2, b2, f2, w3, b3):
    pos = jnp.arange(L, dtype=jnp.float32)
    t = pos / max(L - 1, 1)
    bands = (FILTER_EMB - 1) // 2
    fr = jnp.linspace(1e-4, bands - 1, bands, dtype=jnp.float32)
    ang = 2.0 * math.pi * pos[:, None] * fr[None, :] / L
    feat = jnp.concatenate([t[:, None], jnp.cos(ang), -jnp.sin(ang)], axis=-1)
    h = jnp.sin(f1 * (feat @ w1 + b1))
    h = jnp.sin(f2 * (h @ w2 + b2))
    h = (h @ w3 + b3).reshape(L, HYENA_ORDER, 2, HYENA_WIDTH)
    deltas = jnp.linspace(math.log(DECAY_TARGET) / FAST_DECAY_PCT,
                          math.log(DECAY_TARGET) / SLOW_DECAY_PCT, HYENA_WIDTH, dtype=jnp.float32)
    decay = jnp.exp(-t[:, None] * jnp.abs(deltas)[None, :])
    h = h * decay[:, None, None, :]
    spec = jnp.fft.rfft(h, n=2 * L, axis=0)
    return spec[:, :, 0] + jnp.conj(spec[:, :, 1])


def long_conv(z, Hn):
    L = z.shape[1]
    Z = jnp.fft.rfft(z, n=2 * L, axis=1)
    return jnp.fft.irfft(Z * Hn[None], n=2 * L, axis=1)[:, :L]


def hyena_mixer(u, conv_w, conv_b, skip, spectra):
    u = short_conv(u, conv_w, conv_b)
    z, x1, x2 = jnp.split(u, 3, axis=-1)
    gates = (x1, x2)
    for n in range(HYENA_ORDER):
        z = gates[n] * (long_conv(z, spectra[:, n]) + skip[n] * z)
    return z


def encoder_layer(x, mix_norm, w_in, q_norm, k_norm, hy_conv_w, hy_conv_b,
                  flt_w1, flt_b1, flt_freq1, flt_w2, flt_b2, flt_freq2, flt_w3, flt_b3,
                  hy_skip, attn_out_norm, hy_out_norm, w_out, ffn_norm, w_up, w_down):
    B, S, _ = x.shape
    f32 = jnp.float32
    xn = rmsnorm(x, mix_norm)
    proj = xn @ w_in
    a = ATTN_WIDTH
    q = proj[..., 0:a].astype(f32).reshape(B, S, N_HEADS, HEAD_DIM)
    k = proj[..., a:2 * a].astype(f32).reshape(B, S, N_HEADS, HEAD_DIM)
    v = proj[..., 2 * a:3 * a].astype(f32).reshape(B, S, N_HEADS, HEAD_DIM)
    u = proj[..., 3 * a:].astype(f32)
    q = rope(rmsnorm_f32(q, q_norm))
    k = rope(rmsnorm_f32(k, k_norm))
    attn = dilated_attention(q, k, v).reshape(B, S, ATTN_WIDTH)

    spectra = implicit_filter_spectra(S, flt_w1.astype(f32), flt_b1.astype(f32), flt_freq1.astype(f32),
                                      flt_w2.astype(f32), flt_b2.astype(f32), flt_freq2.astype(f32),
                                      flt_w3.astype(f32), flt_b3.astype(f32))
    hy = hyena_mixer(u, hy_conv_w.astype(f32), hy_conv_b.astype(f32), hy_skip.astype(f32), spectra)

    mixed = jnp.concatenate([rmsnorm_f32(attn, attn_out_norm), rmsnorm_f32(hy, hy_out_norm)], axis=-1)
    h = x + mixed.astype(x.dtype) @ w_out

    hn = rmsnorm(h, ffn_norm)
    ff = jnp.square(jax.nn.relu(hn @ w_up))
    return h + ff @ w_down


def trunk(x, mix_norm, w_in, q_norm, k_norm, hy_conv_w, hy_conv_b,
          flt_w1, flt_b1, flt_freq1, flt_w2, flt_b2, flt_freq2, flt_w3, flt_b3,
          hy_skip, attn_out_norm, hy_out_norm, w_out, ffn_norm, w_up, w_down):
    for i in range(DEPTH):
        x = encoder_layer(x, mix_norm[i], w_in[i], q_norm[i], k_norm[i], hy_conv_w[i], hy_conv_b[i],
                          flt_w1[i], flt_b1[i], flt_freq1[i], flt_w2[i], flt_b2[i], flt_freq2[i],
                          flt_w3[i], flt_b3[i], hy_skip[i], attn_out_norm[i], hy_out_norm[i],
                          w_out[i], ffn_norm[i], w_up[i], w_down[i])
    return x


def setup_inputs(seed: int = 0) -> dict:
    key = jax.random.key(seed)
    ks = jax.random.split(key, 24)
    f32 = jnp.float32

    def nrm(k, shape, scale):
        return jax.random.normal(k, shape, f32) * scale

    def gain(k, shape):
        return 1.0 + 0.02 * jax.random.normal(k, shape, f32)

    C = HYENA_WIDTH
    return {
        "x_prompt": nrm(ks[0], (BATCH, SEQ, D_MODEL), 1.0),
        "x_sample": nrm(ks[1], (DEC_BATCH, DEC_SEQ, D_MODEL), 1.0),
        "mix_norm": gain(ks[2], (DEPTH, D_MODEL)),
        "w_in": nrm(ks[3], (DEPTH, D_MODEL, IN_WIDTH), D_MODEL ** -0.5),
        "q_norm": gain(ks[4], (DEPTH, HEAD_DIM)),
        "k_norm": gain(ks[5], (DEPTH, HEAD_DIM)),
        "hy_conv_w": nrm(ks[6], (DEPTH, SHORT_CONV, 3 * C), SHORT_CONV ** -0.5),
        "hy_conv_b": nrm(ks[7], (DEPTH, 3 * C), 0.02),
        "flt_w1": nrm(ks[8], (DEPTH, FILTER_EMB, FILTER_HIDDEN), FILTER_EMB ** -0.5),
        "flt_b1": nrm(ks[9], (DEPTH, FILTER_HIDDEN), 0.02),
        "flt_freq1": gain(ks[10], (DEPTH, FILTER_HIDDEN)),
        "flt_w2": nrm(ks[11], (DEPTH, FILTER_HIDDEN, FILTER_HIDDEN), FILTER_HIDDEN ** -0.5),
        "flt_b2": nrm(ks[12], (DEPTH, FILTER_HIDDEN), 0.02),
        "flt_freq2": gain(ks[13], (DEPTH, FILTER_HIDDEN)),
        "flt_w3": nrm(ks[14], (DEPTH, FILTER_HIDDEN, FILTER_OUT), FILTER_HIDDEN ** -0.5),
        "flt_b3": nrm(ks[15], (DEPTH, FILTER_OUT), 0.02),
        "hy_skip": nrm(ks[16], (DEPTH, HYENA_ORDER, C), 0.5),
        "attn_out_norm": gain(ks[17], (DEPTH, ATTN_WIDTH)),
        "hy_out_norm": gain(ks[18], (DEPTH, HYENA_WIDTH)),
        "w_out": nrm(ks[19], (DEPTH, D_MODEL, D_MODEL), D_MODEL ** -0.5),
        "ffn_norm": gain(ks[20], (DEPTH, D_MODEL)),
        "w_up": nrm(ks[21], (DEPTH, D_MODEL, D_FF), D_MODEL ** -0.5),
        "w_down": nrm(ks[22], (DEPTH, D_FF, D_MODEL), D_FF ** -0.5),
    }


def reference(x_prompt, x_sample, mix_norm, w_in, q_norm, k_norm, hy_conv_w, hy_conv_b,
              flt_w1, flt_b1, flt_freq1, flt_w2, flt_b2, flt_freq2, flt_w3, flt_b3,
              hy_skip, attn_out_norm, hy_out_norm, w_out, ffn_norm, w_up, w_down):
    y_prompt = trunk(x_prompt, mix_norm, w_in, q_norm, k_norm, hy_conv_w, hy_conv_b,
                     flt_w1, flt_b1, flt_freq1, flt_w2, flt_b2, flt_freq2, flt_w3, flt_b3,
                     hy_skip, attn_out_norm, hy_out_norm, w_out, ffn_norm, w_up, w_down)
    y_sample = trunk(x_sample, mix_norm, w_in, q_norm, k_norm, hy_conv_w, hy_conv_b,
                     flt_w1, flt_b1, flt_freq1, flt_w2, flt_b2, flt_freq2, flt_w3, flt_b3,
                     hy_skip, attn_out_norm, hy_out_norm, w_out, ffn_norm, w_up, w_down)
    return (y_prompt, y_sample)
```

```cpp
#include <hip/hip_runtime.h>
#include <hip/hip_cooperative_groups.h>
#include <cstdio>
#include <cstdint>
namespace cg = cooperative_groups;
namespace pg8 {
#define PG8_LAS __attribute__((address_space(3)))
typedef unsigned short bf16_t;
typedef short bf16x8 __attribute__((ext_vector_type(8)));
typedef float f32x4 __attribute__((ext_vector_type(4)));
typedef unsigned u32x4 __attribute__((ext_vector_type(4)));
constexpr int BM = 256, BK = 64, HALF = 128, HTB = HALF * BK * 2  , STAGE_BYTES = 8 * HTB, NXCD = 8, WGM = 8;

__host__ __device__ __forceinline__ int lds_byte(int r, int c) { const int st = (r >> 4) * 2 + (c >> 5), rr = r & 15, cc = c & 31, ob = rr * 64 + cc * 2; return st * 1024 + (ob ^ (((ob >> 9) & 1) << 5)); }
__host__ __device__ __forceinline__ void stage_rc(int b, int& R, int& C) { const int st = b / 1024, sb = b % 1024, swz = sb ^ (((sb >> 9) & 1) << 5); R = (st >> 1) * 16 + swz / 64; C = (st & 1) * 32 + (swz % 64) / 2; }
__host__ __device__ __forceinline__ int perm32(int rho) { const int n = rho >> 4, i = rho & 15; return 8 * (i >> 2) + 4 * n + (i & 3); }

struct Unit { int pm, pn; };
struct Gemm { const bf16_t* A; const bf16_t* Bt; int M, N, K; };

struct StaticOrder {
    int nM, nN, nwg, G, c;
    __host__ __device__ void init(int M, int N, int G_, int c_) { nM = M / BM; nN = N / BM; nwg = nM * nN; G = G_; c = c_; }
    __host__ __device__ bool next(int i, Unit& u) const {
        const long L = (long)i * G + c; if (L >= nwg) return false;
        int wgid = (int)L; { const int q = nwg / NXCD, r = nwg % NXCD, xcd = wgid % NXCD, off = wgid / NXCD; wgid = (xcd < r ? xcd * (q + 1) : r * (q + 1) + (xcd - r) * q) + off; }
        const int nig = WGM * nN, gid = wgid / nig, fm = gid * WGM, gsz = (nM - fm) < WGM ? (nM - fm) : WGM;
        u.pm = fm + ((wgid % nig) % gsz); u.pn = (wgid % nig) / gsz; return true;
    }
    __device__ __forceinline__ void a_ready(const Unit&) const {}
    __device__ __forceinline__ void done(const Unit&) const {}
};


template <class Epi, class Sched, bool ALIGN_EPI = false, bool SP2 = false>
__device__ __forceinline__ void gemm_phase(PG8_LAS unsigned char* lds, const Gemm g, const Sched& S, const Epi& E) {
    const int tid = threadIdx.x, wid = __builtin_amdgcn_readfirstlane(tid >> 6), lane = tid & 63, wr = wid >> 2, wc = wid & 3, fr = lane & 15, fq = lane >> 4;
    const int K = g.K, nt = K / BK;
    unsigned voffA[2], voffB[2];
#pragma unroll
    for (int i = 0; i < 2; ++i) { int R, C; stage_rc(tid * 16 + i * 8192, R, C); const int Rb = Epi::PERM ? ((R & ~31) + perm32(R & 31)) : R;
        voffA[i] = Epi::ABLK ? (unsigned)(R * 64 + C) * 2u : (unsigned)(R * K + C) * 2u; voffB[i] = (unsigned)(Rb * K + C) * 2u; }
    const size_t kstep = (size_t)(BK * 2);
    const size_t hstep = (size_t)HALF * K * 2;
    const size_t tstep = 2 * hstep;
    const size_t kstepA = Epi::ABLK ? (size_t)(256 * 64 * 2) : kstep, hstepA = Epi::ABLK ? (size_t)(128 * 64 * 2) : hstep, tstepA = Epi::ABLK ? (size_t)(K / 64) * (256 * 64 * 2) : tstep;
    const unsigned ldsw = (unsigned)wid * 1024u;
    const int aoff = lds_byte(wr * 64 + fr, fq * 8), boff = lds_byte(wc * 32 + fr, fq * 8);
#define PG8_SA(b, h) (((b) * 2 + (h)) * HTB)
#define PG8_SB(b, h) ((4 + (b) * 2 + (h)) * HTB)
#define PG8_STAGE(bufoff, gbase, voff) do { _Pragma("unroll") for (int _i = 0; _i < 2; ++_i) \
        __builtin_amdgcn_global_load_lds((const unsigned*)((const char*)(gbase) + (voff)[_i]), (PG8_LAS unsigned*)(lds + (bufoff) + ldsw + _i * 8192), 16, 0, 0); } while (0)
#define PG8_LDA(dst, b, h) do { _Pragma("unroll") for (int m = 0; m < 4; ++m) _Pragma("unroll") for (int k = 0; k < 2; ++k) dst[m][k] = *(const PG8_LAS bf16x8*)(lds + PG8_SA(b, h) + aoff + m * 2048 + k * 1024); } while (0)
#define PG8_LDB(dst, b, h) do { _Pragma("unroll") for (int n = 0; n < 2; ++n) _Pragma("unroll") for (int k = 0; k < 2; ++k) dst[n][k] = *(const PG8_LAS bf16x8*)(lds + PG8_SB(b, h) + boff + n * 2048 + k * 1024); } while (0)
#define PG8_MMA(ai, bj, At, Bt) do { __builtin_amdgcn_s_setprio(1); _Pragma("unroll") for (int m = 0; m < 4; ++m) _Pragma("unroll") for (int n = 0; n < 2; ++n) _Pragma("unroll") for (int k = 0; k < 2; ++k) \
        acc[ai][bj][m][n] = __builtin_amdgcn_mfma_f32_16x16x32_bf16(Bt[n][k], At[m][k], acc[ai][bj][m][n], 0, 0, 0); __builtin_amdgcn_s_setprio(0); } while (0)
#define PG8_WAIT_V(n) asm volatile("s_waitcnt vmcnt(" #n ")" ::: "memory")
#define PG8_WAIT_L(n) asm volatile("s_waitcnt lgkmcnt(" #n ")" ::: "memory")
#define PG8_BAR __builtin_amdgcn_s_barrier()
#define PG8_SCHED __builtin_amdgcn_sched_barrier(0)
    Unit cur, nxt; int ui = 0;
    if (!S.next(0, cur)) return;
    f32x4 acc[2][2][4][2];
#pragma unroll
    for (int a = 0; a < 2; ++a)
#pragma unroll
        for (int b = 0; b < 2; ++b)
#pragma unroll
            for (int m = 0; m < 4; ++m)
#pragma unroll
                for (int n = 0; n < 2; ++n) acc[a][b][m][n] = (f32x4){0.f, 0.f, 0.f, 0.f};
    bf16x8 At[4][2], B0[2][2], B1[2][2];
    const char* cA = (const char*)g.A + (size_t)cur.pm * tstepA; const char* cB = (const char*)g.Bt + (size_t)cur.pn * tstep;
    S.a_ready(cur);
    if constexpr (SP2) {
        PG8_STAGE(PG8_SB(0, 0), cB, voffB); PG8_STAGE(PG8_SB(0, 1), cB + hstep, voffB); PG8_STAGE(PG8_SA(0, 0), cA, voffA); PG8_STAGE(PG8_SA(0, 1), cA + hstepA, voffA);
        if (wr == 1) PG8_BAR;
        PG8_WAIT_V(2); PG8_BAR;
        PG8_STAGE(PG8_SB(1, 0), cB + kstep, voffB); PG8_STAGE(PG8_SA(1, 0), cA + kstepA, voffA); PG8_STAGE(PG8_SB(1, 1), cB + hstep + kstep, voffB);
        PG8_WAIT_V(6); PG8_BAR;
    } else {
        PG8_STAGE(PG8_SB(0, 0), cB, voffB); PG8_STAGE(PG8_SA(0, 0), cA, voffA); PG8_STAGE(PG8_SB(0, 1), cB + hstep, voffB); PG8_STAGE(PG8_SA(0, 1), cA + hstepA, voffA);
        if (wr == 1) PG8_BAR;
        PG8_WAIT_V(4); PG8_BAR;
        PG8_STAGE(PG8_SB(1, 0), cB + kstep, voffB); PG8_STAGE(PG8_SA(1, 0), cA + kstepA, voffA); PG8_STAGE(PG8_SB(1, 1), cB + hstep + kstep, voffB);
        PG8_WAIT_V(6); PG8_BAR;
    }
    for (;;) {
        const bool has_next = S.next(ui + 1, nxt);
        const char* nA = has_next ? (const char*)g.A + (size_t)nxt.pm * tstepA : cA; const char* nB = has_next ? (const char*)g.Bt + (size_t)nxt.pn * tstep : cB;
        for (int t = 0; t < nt; t += 2) {
            const bool last = (t == nt - 2);
            const char* a1 = cA + (size_t)(t + 1) * kstepA;
            const char* a2 = last ? nA : cA + (size_t)(t + 2) * kstepA; const char* b2 = last ? nB : cB + (size_t)(t + 2) * kstep;
            const char* a3 = a2 + kstepA; const char* b3 = b2 + kstep;
            if (last && has_next) S.a_ready(nxt);
            if constexpr (SP2) {
            PG8_LDB(B0, 0, 0); PG8_LDB(B1, 0, 1); PG8_SCHED; PG8_LDA(At, 0, 0); PG8_STAGE(PG8_SA(1, 1), a1 + hstepA, voffA);
            PG8_WAIT_V(8); PG8_WAIT_L(0); PG8_BAR; PG8_MMA(0, 0, At, B0); PG8_MMA(0, 1, At, B1); PG8_BAR; PG8_SCHED;
            PG8_LDA(At, 0, 1); PG8_STAGE(PG8_SB(0, 0), b2, voffB); PG8_STAGE(PG8_SB(0, 1), b2 + hstep, voffB); PG8_STAGE(PG8_SA(0, 0), a2, voffA);
            PG8_WAIT_V(8); PG8_WAIT_L(0); PG8_BAR; PG8_MMA(1, 0, At, B0); PG8_MMA(1, 1, At, B1); PG8_BAR; PG8_SCHED;
            PG8_LDB(B0, 1, 0); PG8_LDB(B1, 1, 1); PG8_SCHED; PG8_LDA(At, 1, 0); PG8_STAGE(PG8_SA(0, 1), a2 + hstepA, voffA);
            PG8_WAIT_V(8); PG8_WAIT_L(0); PG8_BAR; PG8_MMA(0, 0, At, B0); PG8_MMA(0, 1, At, B1); PG8_BAR; PG8_SCHED;
            PG8_LDA(At, 1, 1); PG8_STAGE(PG8_SB(1, 0), b3, voffB); PG8_STAGE(PG8_SB(1, 1), b3 + hstep, voffB); PG8_STAGE(PG8_SA(1, 0), a3, voffA);
            PG8_WAIT_V(8); PG8_WAIT_L(0); PG8_BAR; PG8_MMA(1, 0, At, B0); PG8_MMA(1, 1, At, B1); PG8_BAR; PG8_SCHED;
            } else {
            PG8_LDB(B0, 0, 0); PG8_SCHED; PG8_LDA(At, 0, 0); PG8_STAGE(PG8_SA(1, 1), a1 + hstepA, voffA);
            PG8_WAIT_L(8); PG8_BAR; PG8_WAIT_L(0); PG8_MMA(0, 0, At, B0); PG8_BAR; PG8_SCHED;
            PG8_LDB(B1, 0, 1); PG8_STAGE(PG8_SB(0, 0), b2, voffB);
            PG8_BAR; PG8_WAIT_L(0); PG8_MMA(0, 1, At, B1); PG8_BAR;
            PG8_LDA(At, 0, 1); PG8_STAGE(PG8_SA(0, 0), a2, voffA);
            PG8_BAR; PG8_WAIT_L(0); PG8_MMA(1, 0, At, B0); PG8_BAR; PG8_SCHED;
            PG8_STAGE(PG8_SB(0, 1), b2 + hstep, voffB);
            PG8_WAIT_V(6); PG8_BAR; PG8_MMA(1, 1, At, B1); PG8_BAR;
            PG8_LDB(B0, 1, 0); PG8_SCHED; PG8_LDA(At, 1, 0); PG8_STAGE(PG8_SA(0, 1), a2 + hstepA, voffA);
            PG8_WAIT_L(8); PG8_BAR; PG8_WAIT_L(0); PG8_MMA(0, 0, At, B0); PG8_BAR; PG8_SCHED;
            PG8_LDB(B1, 1, 1); PG8_STAGE(PG8_SB(1, 0), b3, voffB);
            PG8_BAR; PG8_WAIT_L(0); PG8_MMA(0, 1, At, B1); PG8_BAR;
            PG8_LDA(At, 1, 1); PG8_STAGE(PG8_SA(1, 0), a3, voffA);
            PG8_BAR; PG8_WAIT_L(0); PG8_MMA(1, 0, At, B0); PG8_BAR; PG8_SCHED;
            PG8_STAGE(PG8_SB(1, 1), b3 + hstep, voffB);
            PG8_WAIT_V(6); PG8_BAR; PG8_MMA(1, 1, At, B1); PG8_BAR;
            }
        }
        if constexpr (ALIGN_EPI) { if (wr == 0) PG8_BAR; }
        if constexpr (!Epi::AFTER_DRAIN) { E(acc, cur, wr, wc, fr, fq); S.done(cur); }
        if (!has_next) break;
#pragma unroll
        for (int a = 0; a < 2; ++a)
#pragma unroll
            for (int b = 0; b < 2; ++b)
#pragma unroll
                for (int m = 0; m < 4; ++m)
#pragma unroll
                    for (int n = 0; n < 2; ++n) acc[a][b][m][n] = (f32x4){0.f, 0.f, 0.f, 0.f};
        cur = nxt; cA = nA; cB = nB; ++ui;
        if constexpr (ALIGN_EPI) { if (wr == 1) PG8_BAR; }
    }
    PG8_WAIT_V(0);
    if constexpr (!ALIGN_EPI) { if (wr == 0) PG8_BAR; }
    PG8_BAR;
    if constexpr (Epi::AFTER_DRAIN) { E.fused(acc, cur, wr, wc, fr, fq, lds, wid, lane); S.done(cur); }
#undef PG8_SA
#undef PG8_SB
#undef PG8_STAGE
#undef PG8_LDA
#undef PG8_LDB
#undef PG8_MMA
#undef PG8_WAIT_V
#undef PG8_WAIT_L
#undef PG8_BAR
#undef PG8_SCHED
}
}
#define LAS __attribute__((address_space(3)))
#include <hip/hip_runtime.h>
#include <cstdio>
#include <cstdint>
#include <cstdlib>
#include <vector>

#define XB_TMO      128
#define XB_XCNT(j)  (256  + 64 * (j))
#define XB_XSUB(j)  (1280 + 64 * (j))
#define XB_XGEN(j)  (2304 + 64 * (j))
#define XB_TOP      3328
#define XB_TOPGEN   3392
#define XCD_BAR_WORDS 3456
#define XB_SPIN_CAP (1u << 18)

__device__ __forceinline__ unsigned xb_ld(unsigned* p)              { return __hip_atomic_load(p, __ATOMIC_RELAXED, __HIP_MEMORY_SCOPE_AGENT); }
__device__ __forceinline__ unsigned xb_add(unsigned* p, unsigned v) { return __hip_atomic_fetch_add(p, v, __ATOMIC_RELAXED, __HIP_MEMORY_SCOPE_AGENT); }
__device__ __forceinline__ unsigned xb_xcc_id() { return (unsigned)__builtin_amdgcn_s_getreg((3 << 11) | 20) & 0xFu; }
#define XB_SPIN(cond, bar) do { unsigned _sp = 0; while (cond) { __builtin_amdgcn_s_sleep(1); \
    if ((++_sp & 255u) == 0u) { if (xb_ld(&(bar)[XB_TMO])) break; if (_sp > XB_SPIN_CAP) { atomicAdd(&(bar)[XB_TMO], 1u); break; } } } } while (0)

struct XcdBarrier {
    unsigned* bar; unsigned x;
    volatile LAS unsigned* st;
};

__device__ __forceinline__ XcdBarrier xcd_barrier_post(unsigned* bar, volatile LAS unsigned* st) {
    XcdBarrier b; b.bar = bar; b.x = xb_xcc_id(); b.st = st;
    if (threadIdx.x == 0) (void)xb_add(&bar[XB_XCNT(b.x)], 1u);
    return b;
}
__device__ __forceinline__ void xcd_barrier_complete(unsigned* bar, unsigned x, unsigned& nloc, unsigned& nx) {
    const unsigned G = gridDim.x * gridDim.y * gridDim.z;
    unsigned sum, cnt, mine, sp = 0u;
    for (;;) {
        sum = 0u; cnt = 0u; mine = 0u;
#pragma unroll
        for (unsigned j = 0; j < 16; ++j) { const unsigned c = xb_ld(&bar[XB_XCNT(j)]); sum += c; cnt += (c > 0u) ? 1u : 0u; mine = (j == x) ? c : mine; }
        if (sum == G) break;
        __builtin_amdgcn_s_sleep(1);
        if ((++sp & 255u) == 0u) { if (xb_ld(&bar[XB_TMO])) break; if (sp > XB_SPIN_CAP) { atomicAdd(&bar[XB_TMO], 1u); break; } }
    }
    nloc = mine > 0u ? mine : 1u; nx = cnt > 0u ? cnt : 1u;
}

__device__ __forceinline__ void xcd_barrier(const XcdBarrier& b) {
    asm volatile("s_waitcnt vmcnt(0)" ::: "memory");
    __syncthreads();
    if (threadIdx.x == 0) {
        unsigned* bar = b.bar;
        __builtin_amdgcn_s_waitcnt(0);
        unsigned nloc = b.st[0], nx = b.st[1];
        if (nloc == 0u) { xcd_barrier_complete(bar, b.x, nloc, nx); b.st[0] = nloc; b.st[1] = nx; }
        const unsigned old = xb_add(&bar[XB_XSUB(b.x)], 1u);
        const unsigned gen = old / nloc;
        if (old + 1u == (gen + 1u) * nloc) {
            __builtin_amdgcn_fence(__ATOMIC_RELEASE, "agent");
            asm volatile("s_waitcnt vmcnt(0)" ::: "memory");
            const unsigned og = xb_add(&bar[XB_TOP], 1u);
            const unsigned tg = og / nx;
            if (og + 1u == (tg + 1u) * nx) xb_add(&bar[XB_TOPGEN], 1u);
            else XB_SPIN(xb_ld(&bar[XB_TOPGEN]) == tg, bar);
            __builtin_amdgcn_fence(__ATOMIC_ACQUIRE, "agent");
            xb_add(&bar[XB_XGEN(b.x)], 1u);
            asm volatile("s_waitcnt vmcnt(0)" ::: "memory");
        } else {
            XB_SPIN(xb_ld(&bar[XB_XGEN(b.x)]) == gen, bar);
            __builtin_amdgcn_fence(__ATOMIC_ACQUIRE, "agent");
            asm volatile("s_waitcnt vmcnt(0)" ::: "memory");
        }
    }
    __syncthreads();
}


typedef unsigned short bf16_t;
typedef short bf16x8 __attribute__((ext_vector_type(8)));
typedef float f32x4 __attribute__((ext_vector_type(4)));
typedef float f32x2 __attribute__((ext_vector_type(2)));
typedef unsigned u32x4 __attribute__((ext_vector_type(4)));
typedef unsigned u32x2 __attribute__((ext_vector_type(2)));
typedef __bf16 bf16x2_t __attribute__((ext_vector_type(2)));
#define DI __device__ __forceinline__

constexpr int DM = 1024, NBATCH = 40, SEQ = 2048, NTOK = NBATCH * SEQ, NTOK_P = 32 * SEQ;
constexpr int AW = 512, HWID = 512, INW = 3072, DFF = 4096;
constexpr float EPS = 1e-6f;
constexpr float QSCALE = 0.18033688011112042f;
constexpr int LDS_BAR_OFF = 163808;
constexpr int LDS_BYTES = LDS_BAR_OFF + 16;

constexpr size_t WS_WIN = 0;
constexpr size_t WS_WOUT = WS_WIN + (size_t)3072 * 1024 * 2;
constexpr size_t WS_WUP = WS_WOUT + (size_t)1024 * 1024 * 2;
constexpr size_t WS_WDN = WS_WUP + (size_t)4096 * 1024 * 2;
constexpr size_t WS_R = WS_WDN + (size_t)1024 * 4096 * 2;
constexpr size_t WS_CS = WS_R + (size_t)2 * 512 * 4096 * 2;
constexpr size_t WS_RSTD1 = WS_CS + (size_t)2048 * 32 * 8;
constexpr size_t WS_ROWSQ = WS_RSTD1 + (size_t)NTOK * 4;
constexpr size_t WS_L = WS_ROWSQ + (size_t)NTOK * 4;
constexpr size_t WS_HB = WS_L + (size_t)3 * NTOK * 8 * 4;
constexpr size_t WS_A = WS_HB + (size_t)NTOK * 1024 * 2;
constexpr size_t WS_XB = WS_A;
constexpr size_t WS_Q = WS_XB + (size_t)NTOK * 1024 * 2;
constexpr size_t WS_K = WS_Q + (size_t)NTOK * 512 * 2;
constexpr size_t WS_V = WS_K + (size_t)NTOK * 512 * 2;
constexpr size_t WS_UT = WS_V + (size_t)NTOK * 512 * 2;
constexpr size_t WS_END = WS_UT + (size_t)1536 * NTOK * 2;
static_assert(WS_END - WS_A == (size_t)NTOK * 4096 * 2, "fbuf overlay");
constexpr size_t WS_BAR = WS_END;
constexpr size_t WS_TOTAL = WS_BAR + 16384;
constexpr size_t OUT_OACC = 0, OUT_HYT = (size_t)3 * NTOK * 512 * 2;

struct Params {
    const float *x_prompt, *x_sample, *mix_norm, *w_in, *q_norm, *k_norm, *hy_conv_w, *hy_conv_b,
        *flt_w1, *flt_b1, *flt_freq1, *flt_w2, *flt_b2, *flt_freq2, *flt_w3, *flt_b3, *hy_skip,
        *attn_out_norm, *hy_out_norm, *w_out, *ffn_norm, *w_up, *w_down;
    float* out; unsigned char* ws; int ph_lo, ph_hi;
};

DI unsigned pk2(float a, float b) { f32x2 v = {a, b}; bf16x2_t r = __builtin_convertvector(v, bf16x2_t); return __builtin_bit_cast(unsigned, r); }
DI float bf_lo(unsigned u) { return __uint_as_float(u << 16); }
DI float bf_hi(unsigned u) { return __uint_as_float(u & 0xffff0000u); }
DI float bf1(bf16_t b) { return __uint_as_float((unsigned)b << 16); }
DI float wave_sum(float v) { v += __shfl_xor(v, 1); v += __shfl_xor(v, 2); v += __shfl_xor(v, 4); v += __shfl_xor(v, 8); v += __shfl_xor(v, 16); v += __shfl_xor(v, 32); return v; }
DI const float* xrow(const Params& p, int row) { return row < NTOK_P ? p.x_prompt + (size_t)row * DM : p.x_sample + (size_t)(row - NTOK_P) * DM; }

using pg8::Unit;
struct EpiQKV {
    static constexpr bool PERM = true, AFTER_DRAIN = false, ABLK = false;
    bf16_t* qkv; const float* rstd1; const float *qn, *kn; const f32x2* cs;
    DI void operator()(const f32x4 (&acc)[2][2][4][2], const Unit& u, int wr, int wc, int fr, int fq) const {
        const int kind = u.pn >> 1;
        bf16_t* dst = qkv + (size_t)kind * ((size_t)NTOK * 512);
        const int fbase = (u.pn & 1) * 256 + wc * 64 + 8 * fq;
        f32x4 g[2][2];
        if (kind < 2) { const float* gn = kind == 0 ? qn : kn;
#pragma unroll
            for (int bj = 0; bj < 2; ++bj)
#pragma unroll
                for (int n = 0; n < 2; ++n) g[bj][n] = *(const f32x4*)(gn + 32 * bj + 8 * fq + 4 * n); }
#pragma unroll
        for (int ai = 0; ai < 2; ++ai)
#pragma unroll
            for (int m = 0; m < 4; ++m) {
                const int row = u.pm * 256 + ai * 128 + wr * 64 + m * 16 + fr;
                const float rs = rstd1[row];
                f32x4 v[2][2];
#pragma unroll
                for (int bj = 0; bj < 2; ++bj)
#pragma unroll
                    for (int n = 0; n < 2; ++n) v[bj][n] = acc[ai][bj][m][n] * rs;
                if (kind < 2) {
                    float ss = 0.f;
#pragma unroll
                    for (int bj = 0; bj < 2; ++bj)
#pragma unroll
                        for (int n = 0; n < 2; ++n) { const f32x4 x = v[bj][n]; ss += (x[0] * x[0] + x[1] * x[1]) + (x[2] * x[2] + x[3] * x[3]); }
                    ss += __shfl_xor(ss, 16); ss += __shfl_xor(ss, 32);
                    const float hr = __builtin_amdgcn_rsqf(ss * (1.0f / 64.0f) + EPS) * (kind == 0 ? QSCALE : 1.0f);
#pragma unroll
                    for (int bj = 0; bj < 2; ++bj)
#pragma unroll
                        for (int n = 0; n < 2; ++n) v[bj][n] = v[bj][n] * hr * g[bj][n];
                    const f32x2* c = cs + (size_t)(row & (SEQ - 1)) * 32 + 8 * fq;
#pragma unroll
                    for (int n = 0; n < 2; ++n) {
                        const f32x4 c01 = *(const f32x4*)(c + 4 * n), c23 = *(const f32x4*)(c + 4 * n + 2);
                        const float cc[4] = {c01[0], c01[2], c23[0], c23[2]}, sn[4] = {c01[1], c01[3], c23[1], c23[3]};
#pragma unroll
                        for (int j = 0; j < 4; ++j) { const float x1 = v[0][n][j], x2 = v[1][n][j]; v[0][n][j] = x1 * cc[j] - x2 * sn[j]; v[1][n][j] = x2 * cc[j] + x1 * sn[j]; }
                    }
                }
                bf16_t* rp = dst + ((size_t)((row >> 11) * 8 + (fbase >> 6)) * SEQ + (row & (SEQ - 1))) * 64 + (fbase & 63);
#pragma unroll
                for (int bj = 0; bj < 2; ++bj) { u32x4 w; w.x = pk2(v[bj][0][0], v[bj][0][1]); w.y = pk2(v[bj][0][2], v[bj][0][3]); w.z = pk2(v[bj][1][0], v[bj][1][1]); w.w = pk2(v[bj][1][2], v[bj][1][3]); *(u32x4*)(rp + 32 * bj) = w; }
            }
    }
};
struct EpiUT {
    static constexpr bool PERM = true, AFTER_DRAIN = false, ABLK = false;
    bf16_t* ut; const float* rstd1;
    DI void operator()(const f32x4 (&acc)[2][2][4][2], const Unit& u, int wr, int wc, int fr, int fq) const {
        const int col0 = u.pn * 256 + wc * 32 + 8 * fq;
        f32x4 rs[2][2];
#pragma unroll
        for (int bj = 0; bj < 2; ++bj)
#pragma unroll
            for (int n = 0; n < 2; ++n) rs[bj][n] = *(const f32x4*)(rstd1 + col0 + bj * 128 + n * 4);
#pragma unroll
        for (int ai = 0; ai < 2; ++ai)
#pragma unroll
            for (int m = 0; m < 4; ++m) {
                const int row = u.pm * 256 + ai * 128 + wr * 64 + m * 16 + fr;
                bf16_t* rp = ut + (size_t)row * NTOK + col0;
#pragma unroll
                for (int bj = 0; bj < 2; ++bj) { const f32x4 x0 = acc[ai][bj][m][0] * rs[bj][0], x1 = acc[ai][bj][m][1] * rs[bj][1];
                    u32x4 w; w.x = pk2(x0[0], x0[1]); w.y = pk2(x0[2], x0[3]); w.z = pk2(x1[0], x1[1]); w.w = pk2(x1[2], x1[3]); *(u32x4*)(rp + bj * 128) = w; }
            }
    }
};
struct EpiH {
    static constexpr bool PERM = true, AFTER_DRAIN = false, ABLK = true;
    const float *xp, *xs; float* out; bf16_t* hb; float* rowsq;
    DI void operator()(const f32x4 (&acc)[2][2][4][2], const Unit& u, int wr, int wc, int fr, int fq) const {
        const int col0 = u.pn * 256 + wc * 32 + 8 * fq;
#pragma unroll
        for (int ai = 0; ai < 2; ++ai)
#pragma unroll
            for (int m = 0; m < 4; ++m) {
                const int row = u.pm * 256 + ai * 128 + wr * 64 + m * 16 + fr;
                const float* xr = (row < NTOK_P ? xp + (size_t)row * DM : xs + (size_t)(row - NTOK_P) * DM) + col0;
                float ss = 0.f;
#pragma unroll
                for (int bj = 0; bj < 2; ++bj) {
                    const f32x4 h0 = *(const f32x4*)(xr + bj * 128) + acc[ai][bj][m][0], h1 = *(const f32x4*)(xr + bj * 128 + 4) + acc[ai][bj][m][1];
                    *(f32x4*)(out + (size_t)row * DM + col0 + bj * 128) = h0; *(f32x4*)(out + (size_t)row * DM + col0 + bj * 128 + 4) = h1;
                    u32x4 w; w.x = pk2(h0[0], h0[1]); w.y = pk2(h0[2], h0[3]); w.z = pk2(h1[0], h1[1]); w.w = pk2(h1[2], h1[3]); *(u32x4*)(hb + (((size_t)u.pm * (DM / 64) + (u.pn * 4 + bj * 2 + (wc >> 1))) * 256 + (row & 255)) * 64 + (wc & 1) * 32 + 8 * fq) = w;
                    ss += (h0[0] * h0[0] + h0[1] * h0[1]) + (h0[2] * h0[2] + h0[3] * h0[3]) + (h1[0] * h1[0] + h1[1] * h1[1]) + (h1[2] * h1[2] + h1[3] * h1[3]);
                }
                ss += __shfl_xor(ss, 16); ss += __shfl_xor(ss, 32);
                if (fq == 0) atomicAdd(rowsq + row, ss);
            }
    }
};
struct EpiUp {
    static constexpr bool PERM = true, AFTER_DRAIN = false, ABLK = true;
    bf16_t* f;
    DI void operator()(const f32x4 (&acc)[2][2][4][2], const Unit& u, int wr, int wc, int fr, int fq) const {
#pragma unroll
        for (int ai = 0; ai < 2; ++ai)
#pragma unroll
            for (int m = 0; m < 4; ++m) {
                const int r = ai * 128 + wr * 64 + m * 16 + fr;
#pragma unroll
                for (int bj = 0; bj < 2; ++bj) { f32x4 x0 = acc[ai][bj][m][0], x1 = acc[ai][bj][m][1];
#pragma unroll
                    for (int j = 0; j < 4; ++j) { const float r0 = fmaxf(x0[j], 0.f), r1 = fmaxf(x1[j], 0.f); x0[j] = r0 * r0; x1[j] = r1 * r1; }
                    const int kt = u.pn * 4 + bj * 2 + (wc >> 1);
                    bf16_t* rp = f + (((size_t)u.pm * (DFF / 64) + kt) * 256 + r) * 64 + (wc & 1) * 32 + 8 * fq;
                    u32x4 w; w.x = pk2(x0[0], x0[1]); w.y = pk2(x0[2], x0[3]); w.z = pk2(x1[0], x1[1]); w.w = pk2(x1[2], x1[3]); *(u32x4*)rp = w; }
            }
    }
};
struct EpiDown {
    static constexpr bool PERM = true, AFTER_DRAIN = false, ABLK = true;
    float* out; const float* rowsq;
    DI void operator()(const f32x4 (&acc)[2][2][4][2], const Unit& u, int wr, int wc, int fr, int fq) const {
        const int col0 = u.pn * 256 + wc * 32 + 8 * fq;
#pragma unroll
        for (int ai = 0; ai < 2; ++ai)
#pragma unroll
            for (int m = 0; m < 4; ++m) {
                const int row = u.pm * 256 + ai * 128 + wr * 64 + m * 16 + fr;
                const float r2 = 1.0f / (rowsq[row] * (1.0f / 1024.0f) + EPS);
                float* rp = out + (size_t)row * DM + col0;
#pragma unroll
                for (int bj = 0; bj < 2; ++bj)
#pragma unroll
                    for (int n = 0; n < 2; ++n) { const f32x4 h = *(const f32x4*)(rp + bj * 128 + n * 4); *(f32x4*)(rp + bj * 128 + n * 4) = h + acc[ai][bj][m][n] * r2; }
            }
    }
};
DI int qkv_rowmap(int f) {
    if (f >= 1536) return f;
    const int fl = f & 255, wc = fl >> 6, bj = (fl >> 5) & 1, x = fl & 31;
    return (f & ~255) + 128 * bj + 32 * wc + x;
}
DI void p0_wtile(const float* W, const float* g0, const float* g1, int K, int N, bf16_t* out, bool perm, int tile, LAS float* tl, int tid) {
    const int ntn = N / 256, kt = tile / ntn, nt = tile % ntn, k0 = kt * 64, n0 = nt * 256;
    float v[32];
#pragma unroll
    for (int i = 0; i < 32; ++i) { const int kk = k0 + i * 2 + (tid >> 8); v[i] = W[(size_t)kk * N + n0 + (tid & 255)]; }
    float gvv[32];
    { const float* ga = g0 ? g0 : W;
#pragma unroll
      for (int i = 0; i < 32; ++i) { const int kk = k0 + i * 2 + (tid >> 8); const float* gp = (g1 && kk >= 512) ? (g1 + (kk - 512)) : (ga + (g0 ? kk : 0)); gvv[i] = *gp; } }
#pragma unroll
    for (int i = 0; i < 32; ++i) { const int k = i * 2 + (tid >> 8);
        tl[(tid & 255) * 65 + k] = v[i] * (g0 ? gvv[i] : 1.f); }
    __syncthreads();
    { const int n = tid >> 1, half = tid & 1; const int r = perm ? qkv_rowmap(n0 + n) : (n0 + n);
      bf16_t* op = out + (size_t)r * K + k0 + 32 * half; const LAS float* tp = tl + n * 65 + 32 * half;
#pragma unroll
      for (int q = 0; q < 4; ++q) { u32x4 w; w.x = pk2(tp[8 * q], tp[8 * q + 1]); w.y = pk2(tp[8 * q + 2], tp[8 * q + 3]); w.z = pk2(tp[8 * q + 4], tp[8 * q + 5]); w.w = pk2(tp[8 * q + 6], tp[8 * q + 7]); *(u32x4*)(op + 8 * q) = w; } }
    __syncthreads();
}
DI void p0_filter(const Params& p, int item, LAS float* sm, int tid) {
    const int tg = item >> 1, n = item & 1;
    LAS float* feat = sm;
    LAS float* h1 = sm + 8 * 34;
    LAS float* h2 = h1 + 8 * 64;
    if (tid < 8 * 33) { const int tt = tid / 33, e = tid % 33; const int t = tg * 8 + tt; float v;
        if (e == 0) v = (float)t / 2047.0f;
        else { const int i = (e - 1) & 15; const double fr = (double)(1e-4f) + (double)i * ((15.0 - 1e-4) / 15.0); double rev = (double)t * fr / 2048.0; rev -= floor(rev);
            float s, c; sincosf((float)(rev * 6.283185307179586), &s, &c); v = (e <= 16) ? c : -s; }
        feat[tt * 34 + e] = v; }
    __syncthreads();
    { const int tt = tid >> 6, k = tid & 63; float a = p.flt_b1[k];
#pragma unroll 11
      for (int e = 0; e < 33; ++e) a += feat[tt * 34 + e] * p.flt_w1[e * 64 + k];
      h1[tt * 64 + k] = sinf(p.flt_freq1[k] * a); }
    __syncthreads();
    { const int tt = tid >> 6, k = tid & 63; float a = p.flt_b2[k];
#pragma unroll 16
      for (int j = 0; j < 64; ++j) a += h1[tt * 64 + j] * p.flt_w2[j * 64 + k];
      h2[k * 8 + tt] = sinf(p.flt_freq2[k] * a); }
    __syncthreads();
    const int c = tid;
    float af[8], ab[8];
    { const float bf_ = p.flt_b3[(2 * n) * 512 + c], bb_ = p.flt_b3[(2 * n + 1) * 512 + c];
#pragma unroll
      for (int tt = 0; tt < 8; ++tt) { af[tt] = bf_; ab[tt] = bb_; } }
#pragma unroll 8
    for (int k = 0; k < 64; ++k) {
        const float wf = p.flt_w3[(size_t)k * 2048 + (2 * n) * 512 + c], wb = p.flt_w3[(size_t)k * 2048 + (2 * n + 1) * 512 + c];
        const f32x4 ha = *(const LAS f32x4*)(h2 + k * 8), hb = *(const LAS f32x4*)(h2 + k * 8 + 4);
#pragma unroll
        for (int tt = 0; tt < 4; ++tt) { af[tt] += ha[tt] * wf; ab[tt] += ha[tt] * wb; af[tt + 4] += hb[tt] * wf; ab[tt + 4] += hb[tt] * wb; }
    }
    const float dl = fabsf(-15.350567286626973f + (float)c * ((-3.0701134573253945f + 15.350567286626973f) / 511.0f));
    bf16_t* R = (bf16_t*)(p.ws + WS_R) + ((size_t)n * 512 + c) * 4096;
#pragma unroll
    for (int tt = 0; tt < 8; ++tt) { const int t = tg * 8 + tt; const float dec = expf(-((float)t / 2047.0f) * dl); af[tt] *= dec; ab[tt] *= dec; }
    if (tg == 0) { ab[0] += af[0]; R[0] = 0; }
    u32x4 w; w.x = pk2(ab[0], ab[1]); w.y = pk2(ab[2], ab[3]); w.z = pk2(ab[4], ab[5]); w.w = pk2(ab[6], ab[7]);
    *(u32x4*)(R + 2048 + tg * 8) = w;
#pragma unroll
    for (int tt = 0; tt < 8; ++tt) { const int t = tg * 8 + tt; if (t > 0) R[2048 - t] = (bf16_t)(pk2(af[tt], 0.f) & 0xffffu); }
    __syncthreads();
}
constexpr int P0_NW = 192 + 64 + 256 + 256, P0_NF = 512, P0_NR = 128, P0_NX = NTOK / 32;
DI void p0_prep(const Params& p, LAS unsigned char* lds, int G, int bid) {
    const int tid = threadIdx.x, lane = tid & 63, wave = tid >> 6;
    LAS float* sm = (LAS float*)lds;
    const int total = P0_NF + P0_NW + P0_NR + P0_NX;
    const int nper = (total + G - 1) / G, shift = (bid & 1) ? nper / 2 : 0;
    for (int kk = 0; kk < nper; ++kk) {
        int kq = kk + shift; if (kq >= nper) kq -= nper;
        const int it = bid + kq * G; if (it >= total) continue;
        int i = it;
        if (i < P0_NF) { p0_filter(p, i, sm, tid); continue; }
        i -= P0_NF;
        if (i < P0_NW) {
            if (i < 192) p0_wtile(p.w_in, p.mix_norm, nullptr, 1024, 3072, (bf16_t*)(p.ws + WS_WIN), true, i, sm, tid);
            else if (i < 256) p0_wtile(p.w_out, p.attn_out_norm, p.hy_out_norm, 1024, 1024, (bf16_t*)(p.ws + WS_WOUT), false, i - 192, sm, tid);
            else if (i < 512) p0_wtile(p.w_up, p.ffn_norm, nullptr, 1024, 4096, (bf16_t*)(p.ws + WS_WUP), false, i - 256, sm, tid);
            else p0_wtile(p.w_down, nullptr, nullptr, 4096, 1024, (bf16_t*)(p.ws + WS_WDN), false, i - 512, sm, tid);
            continue; }
        i -= P0_NW;
        if (i < P0_NR) { const int id = i * 512 + tid, s = id >> 5, fi = id & 31;
            const float inv = powf(10000.0f, -(float)fi / 32.0f); const float ang = (float)s * inv; float sn, cs_; sincosf(ang, &sn, &cs_);
            ((f32x2*)(p.ws + WS_CS))[id] = (f32x2){cs_, sn}; continue; }
        i -= P0_NR;
        { const int row0 = (i * 8 + wave) * 4;
          f32x4 v[4][4];
#pragma unroll
          for (int r = 0; r < 4; ++r) { const float* src = xrow(p, row0 + r);
#pragma unroll
              for (int q = 0; q < 2; ++q) { v[r][2 * q] = *(const f32x4*)(src + q * 512 + lane * 8); v[r][2 * q + 1] = *(const f32x4*)(src + q * 512 + lane * 8 + 4); } }
#pragma unroll
          for (int r = 0; r < 4; ++r) { bf16_t* dst = (bf16_t*)(p.ws + WS_XB) + (size_t)(row0 + r) * DM; float ss = 0.f;
#pragma unroll
              for (int q = 0; q < 2; ++q) { const f32x4 x = v[r][2 * q], y = v[r][2 * q + 1];
                  ss += (x[0] * x[0] + x[1] * x[1]) + (x[2] * x[2] + x[3] * x[3]) + (y[0] * y[0] + y[1] * y[1]) + (y[2] * y[2] + y[3] * y[3]);
                  u32x4 w; w.x = pk2(x[0], x[1]); w.y = pk2(x[2], x[3]); w.z = pk2(y[0], y[1]); w.w = pk2(y[2], y[3]); *(u32x4*)(dst + q * 512 + lane * 8) = w; }
              ss = wave_sum(ss);
              if (lane == 0) { ((float*)(p.ws + WS_RSTD1))[row0 + r] = __builtin_amdgcn_rsqf(ss * (1.0f / 1024.0f) + EPS); ((float*)(p.ws + WS_ROWSQ))[row0 + r] = 0.f; } } }
    }
}

typedef short s16x4 __attribute__((ext_vector_type(4)));
#define RAW_BAR() do { asm volatile("s_waitcnt lgkmcnt(0)" ::: "memory"); __builtin_amdgcn_s_barrier(); asm volatile("" ::: "memory"); } while (0)
constexpr int AT_KSTR = 144, AT_ROWS = 448, AT_KOFF = 0, AT_VOFF = AT_ROWS * AT_KSTR, AT_OST = 2 * AT_VOFF;
static_assert(AT_OST + 8 * 32 * 128 <= LDS_BAR_OFF, "attention LDS map");
constexpr int AT_ITEMS = NBATCH * 8 * 24;
struct AtItem { int b, h, br, sh, L, cls, blk; };
DI AtItem at_decode(int item) { AtItem a; const int bh = item / 24, sub = item % 24; a.b = bh >> 3; a.h = bh & 7; a.br = sub >> 3; const int s = sub & 7;
    a.sh = 2 * a.br; a.L = SEQ >> a.sh; a.cls = a.br == 0 ? 0 : (a.br == 1 ? (s >> 1) : 2 * s); a.blk = a.br == 0 ? s : (a.br == 1 ? (s & 1) : 0); return a; }
DI size_t at_row_off(const AtItem& a, int j) { int cls = a.cls, i;
    if (a.br == 2) { const int hi = j >= 192 ? 1 : 0; cls += hi; i = j - 192 * hi - 64; } else i = 256 * a.blk - 64 + j;
    i = i < 0 ? 0 : (i >= a.L ? a.L - 1 : i);
    return (size_t)(cls + (i << a.sh)) * 64; }
#define AT_LOAD(itm) do { const AtItem a_ = at_decode(itm); \
    const bf16_t* kb_ = (const bf16_t*)(p.ws + WS_K) + (size_t)(a_.b * 8 + a_.h) * SEQ * 64 + (tid & 7) * 8; const bf16_t* vb_ = (const bf16_t*)(p.ws + WS_V) + (size_t)(a_.b * 8 + a_.h) * SEQ * 64 + (tid & 7) * 8; \
    _Pragma("unroll") for (int i_ = 0; i_ < 6; ++i_) { const size_t off_ = at_row_off(a_, (i_ * 512 + tid) >> 3); kv[i_] = *(const u32x4*)(kb_ + off_); vv[i_] = *(const u32x4*)(vb_ + off_); } \
    { const int qcls_ = a_.cls + (a_.br == 2 ? (w >> 2) : 0), qi0_ = (a_.br == 2 ? 32 * (w & 3) : 256 * a_.blk + 32 * w) + n; \
      const bf16_t* qp_ = (const bf16_t*)(p.ws + WS_Q) + ((size_t)(a_.b * 8 + a_.h) * SEQ + qcls_ + (qi0_ << a_.sh)) * 64 + 8 * kg; const size_t qs_ = (size_t)(16 << a_.sh) * 64; \
      qn[0] = *(const bf16x8*)(qp_); qn[1] = *(const bf16x8*)(qp_ + 32); qn[2] = *(const bf16x8*)(qp_ + qs_); qn[3] = *(const bf16x8*)(qp_ + qs_ + 32); } } while (0)
DI int at_map(int k, int G) { if (G & 7) return k; const int x = k & 7, kk = k >> 3; return (x + 8 * (kk / 24)) * 24 + kk % 24; }
DI void attn_phase(const Params& p, LAS unsigned char* lds, int G, int bid, float Mb) {
    int tid_ = threadIdx.x; asm volatile("" : "+v"(tid_));
    const int tid = tid_, lane = tid & 63, w = __builtin_amdgcn_readfirstlane(tid >> 6), n = lane & 15, kg = lane >> 4;
    LAS unsigned char* Ks = lds + AT_KOFF; LAS unsigned char* Vs = lds + AT_VOFF;
    for (int i = tid; i < 64 * AT_KSTR / 16; i += 512) { *(LAS u32x4*)(Ks + 384 * AT_KSTR + i * 16) = (u32x4){0u, 0u, 0u, 0u}; *(LAS u32x4*)(Vs + 384 * AT_KSTR + i * 16) = (u32x4){0u, 0u, 0u, 0u}; }
    int itk = bid; if (itk >= AT_ITEMS) return;
    int it = at_map(itk, G);
    u32x4 kv[6], vv[6]; bf16x8 qn[4];
    AT_LOAD(it);
    const bf16x8 ones = {(short)0x3f80, (short)0x3f80, (short)0x3f80, (short)0x3f80, (short)0x3f80, (short)0x3f80, (short)0x3f80, (short)0x3f80};
    for (;;) {
#pragma unroll
        for (int i = 0; i < 6; ++i) { const int j = (i * 512 + tid) >> 3; *(LAS u32x4*)(Ks + j * AT_KSTR + (tid & 7) * 16) = kv[i]; *(LAS u32x4*)(Vs + j * AT_KSTR + (tid & 7) * 16) = vv[i]; }
        const bf16x8 qa0 = qn[0], qa1 = qn[1], qb0 = qn[2], qb1 = qn[3];
        const AtItem a = at_decode(it);
        RAW_BAR();
        const int nitk = itk + G; const int nit = nitk < AT_ITEMS ? at_map(nitk, G) : AT_ITEMS;
        if (nit < AT_ITEMS) AT_LOAD(nit);
        const int w3 = w & 3, d16 = a.br == 2 ? 1 : 0;
        const int rowbase = d16 ? 192 * (w >> 2) + 32 * w3 : 32 * w;
        const int wlo = d16 ? -64 + 32 * w3 : 256 * a.blk - 64 + 32 * w;
        const bool edge = wlo < 0 || wlo + 160 > a.L;
        u32x2 pa[10], pb[10];
        pa[9] = (u32x2){0u, 0u}; pb[0] = (u32x2){0u, 0u};
        const LAS unsigned char* kr = Ks + (rowbase + n) * AT_KSTR + kg * 16;
#define AT_SPHASE(EDGE_) do { \
_Pragma("unroll") \
        for (int kt = 0; kt < 10; ++kt) { \
            const bf16x8 k0 = *(const LAS bf16x8*)(kr + kt * 16 * AT_KSTR), k1 = *(const LAS bf16x8*)(kr + kt * 16 * AT_KSTR + 64); \
            bool okr[4]; \
_Pragma("unroll") \
            for (int jj = 0; jj < 4; ++jj) okr[jj] = !(EDGE_) || ((unsigned)(wlo + 16 * kt + 4 * kg + jj) < (unsigned)a.L); \
            if (kt <= 8) { \
                f32x4 s = {-Mb, -Mb, -Mb, -Mb}; \
                s = __builtin_amdgcn_mfma_f32_16x16x32_bf16(k0, qa0, s, 0, 0, 0); s = __builtin_amdgcn_mfma_f32_16x16x32_bf16(k1, qa1, s, 0, 0, 0); \
_Pragma("unroll") \
                for (int jj = 0; jj < 4; ++jj) { float e = __builtin_amdgcn_exp2f(s[jj]); const int r0 = 4 * kg + jj; \
                    bool ok = okr[jj]; if (kt == 0) ok = ok && (r0 >= n); if (kt == 8) ok = ok && (r0 <= n); \
                    s[jj] = ok ? e : 0.f; } \
                pa[kt].x = pk2(s[0], s[1]); pa[kt].y = pk2(s[2], s[3]); \
            } \
            if (kt >= 1) { \
                f32x4 s = {-Mb, -Mb, -Mb, -Mb}; \
                s = __builtin_amdgcn_mfma_f32_16x16x32_bf16(k0, qb0, s, 0, 0, 0); s = __builtin_amdgcn_mfma_f32_16x16x32_bf16(k1, qb1, s, 0, 0, 0); \
_Pragma("unroll") \
                for (int jj = 0; jj < 4; ++jj) { float e = __builtin_amdgcn_exp2f(s[jj]); const int r0 = 4 * kg + jj; \
                    bool ok = okr[jj]; if (kt == 1) ok = ok && (r0 >= n); if (kt == 9) ok = ok && (r0 <= n); \
                    s[jj] = ok ? e : 0.f; } \
                pb[kt].x = pk2(s[0], s[1]); pb[kt].y = pk2(s[2], s[3]); \
            } \
        } \
        } while (0)
        if (edge) AT_SPHASE(true); else AT_SPHASE(false);
#undef AT_SPHASE
        f32x4 oa[4], ob[4], la = {0.f, 0.f, 0.f, 0.f}, lb2 = {0.f, 0.f, 0.f, 0.f};
#pragma unroll
        for (int mt = 0; mt < 4; ++mt) { oa[mt] = (f32x4){0.f, 0.f, 0.f, 0.f}; ob[mt] = (f32x4){0.f, 0.f, 0.f, 0.f}; }
        const LAS unsigned char* vr = Vs + (rowbase + 4 * kg + (n >> 2)) * AT_KSTR + (n & 3) * 8;
#pragma unroll
        for (int ks = 0; ks < 5; ++ks) {
            u32x4 bw; bw.x = pa[2 * ks].x; bw.y = pa[2 * ks].y; bw.z = pa[2 * ks + 1].x; bw.w = pa[2 * ks + 1].y;
            const bf16x8 fa = __builtin_bit_cast(bf16x8, bw);
            bw.x = pb[2 * ks].x; bw.y = pb[2 * ks].y; bw.z = pb[2 * ks + 1].x; bw.w = pb[2 * ks + 1].y;
            const bf16x8 fb = __builtin_bit_cast(bf16x8, bw);
            la = __builtin_amdgcn_mfma_f32_16x16x32_bf16(ones, fa, la, 0, 0, 0); lb2 = __builtin_amdgcn_mfma_f32_16x16x32_bf16(ones, fb, lb2, 0, 0, 0);
#pragma unroll
            for (int mt = 0; mt < 4; ++mt) {
                const s16x4 a0 = __builtin_amdgcn_ds_read_tr16_b64_v4i16((LAS s16x4*)(vr + ks * 32 * AT_KSTR + mt * 32));
                const s16x4 a1 = __builtin_amdgcn_ds_read_tr16_b64_v4i16((LAS s16x4*)(vr + ks * 32 * AT_KSTR + mt * 32 + 16 * AT_KSTR));
                bf16x8 af; af[0] = a0[0]; af[1] = a0[1]; af[2] = a0[2]; af[3] = a0[3]; af[4] = a1[0]; af[5] = a1[1]; af[6] = a1[2]; af[7] = a1[3];
                oa[mt] = __builtin_amdgcn_mfma_f32_16x16x32_bf16(af, fa, oa[mt], 0, 0, 0);
                ob[mt] = __builtin_amdgcn_mfma_f32_16x16x32_bf16(af, fb, ob[mt], 0, 0, 0);
            }
        }
        {
          LAS unsigned char* st = lds + AT_OST + w * (32 * 128);
#pragma unroll
          for (int mt = 0; mt < 4; ++mt) { const int ch = (2 * mt + (kg >> 1)), sub = (kg & 1) * 8;
              u32x2 wv; wv.x = pk2(oa[mt][0], oa[mt][1]); wv.y = pk2(oa[mt][2], oa[mt][3]); *(LAS u32x2*)(st + n * 128 + ((ch ^ (n & 7)) << 4) + sub) = wv;
              wv.x = pk2(ob[mt][0], ob[mt][1]); wv.y = pk2(ob[mt][2], ob[mt][3]); *(LAS u32x2*)(st + (16 + n) * 128 + ((ch ^ (n & 7)) << 4) + sub) = wv; }
          const int qcls = a.cls + (d16 ? (w >> 2) : 0), qi0 = d16 ? 32 * w3 : 256 * a.blk + 32 * w;
          bf16_t* obase = (bf16_t*)((unsigned char*)p.out + OUT_OACC) + (size_t)a.br * NTOK * 512 + ((size_t)(a.b * 8 + a.h) * SEQ + qcls) * 64;
          asm volatile("s_waitcnt lgkmcnt(0)" ::: "memory");
#pragma unroll
          for (int ps = 0; ps < 4; ++ps) { const int r = ps * 8 + (lane >> 3), chn = lane & 7;
              const u32x4 v = *(const LAS u32x4*)(st + r * 128 + ((chn ^ (r & 7)) << 4));
              *(u32x4*)(obase + (size_t)((qi0 + r) << a.sh) * 64 + chn * 8) = v; }
          if (kg == 0) { float* lp = (float*)(p.ws + WS_L) + ((size_t)a.br * NTOK + (size_t)a.b * SEQ + qcls) * 8 + a.h;
              lp[(size_t)((qi0 + n) << a.sh) * 8] = la[0]; lp[(size_t)((qi0 + 16 + n) << a.sh) * 8] = lb2[0]; } }
        RAW_BAR();
        if (nit >= AT_ITEMS) break;
        it = nit; itk = nitk;
    }
}
#undef AT_LOAD

constexpr int HY_ZSTR = 4112, HY_C0 = 16 * HY_ZSTR, HY_C1 = HY_C0 + 8208, HY_GS = HY_C1 + 8208, HY_ITEMS = 512 * 3;
static_assert(HY_GS + 16 * HY_ZSTR <= LDS_BAR_OFF, "hyena LDS map");
DI void hy_load_filter(const Params& p, LAS unsigned char* lds, int order, int c, int tid) {
    const bf16_t* R = (const bf16_t*)(p.ws + WS_R) + ((size_t)order * 512 + c) * 4096;
    const u32x4 a = *(const u32x4*)(R + 8 * tid);
    const unsigned nx = (tid < 511) ? (unsigned)R[8 * tid + 8] : 0u;
    *(LAS u32x4*)(lds + HY_C0 + tid * 16) = a;
    u32x4 s; s.x = (a.x >> 16) | (a.y << 16); s.y = (a.y >> 16) | (a.z << 16); s.z = (a.z >> 16) | (a.w << 16); s.w = (a.w >> 16) | (nx << 16);
    *(LAS u32x4*)(lds + HY_C1 + tid * 16) = s;
}
DI void hy_dma_rows(const Params& p, LAS unsigned char* lds, int f, int bg, int w, int lane) {
    const bf16_t* ut = (const bf16_t*)(p.ws + WS_UT) + (size_t)f * NTOK;
#pragma unroll
    for (int i = 0; i < 8; ++i) { const int seg = w * 8 + i, rn = seg >> 2, q = seg & 3, bb = 16 * bg + rn;
        if (bb < NBATCH) __builtin_amdgcn_global_load_lds((const unsigned*)(ut + (size_t)bb * SEQ + q * 512 + lane * 8), (LAS unsigned*)(lds + HY_GS + rn * HY_ZSTR + q * 1024), 16, 0, 0); }
}
#ifndef HY_NMI
#define HY_NMI 16
#endif
#define HY_NP (16 / HY_NMI)
DI void hyena_item(const Params& p, LAS unsigned char* lds, int item) {
    int tid_ = threadIdx.x; asm volatile("" : "+v"(tid_));
    const int tid = tid_, lane = tid & 63, w = __builtin_amdgcn_readfirstlane(tid >> 6), n = lane & 15, kg = lane >> 4;
    const int c = item / 3, bg = item % 3;
    hy_dma_rows(p, lds, c, bg, w, lane);
    hy_load_filter(p, lds, 0, c, tid);
    asm volatile("s_waitcnt vmcnt(0)" ::: "memory");
    __syncthreads();
    { const float w0 = p.hy_conv_w[c], w1 = p.hy_conv_w[1536 + c], w2 = p.hy_conv_w[3072 + c], cb = p.hy_conv_b[c];
#pragma unroll 2
      for (int it = 0; it < 8; ++it) { const int id = it * 512 + tid, zn = id >> 8, t8 = (id & 255) * 8, bb = 16 * bg + zn;
          u32x4 o = {0u, 0u, 0u, 0u};
          if (bb < NBATCH) { const LAS unsigned char* gp = lds + HY_GS + zn * HY_ZSTR + t8 * 2;
              const u32x4 d = *(const LAS u32x4*)gp; unsigned pm = *(const LAS unsigned*)(gp - 4), nx = *(const LAS unsigned*)(gp + 16);
              pm = t8 > 0 ? pm : 0u; nx = (t8 + 8 < SEQ) ? nx : 0u;
              float u[10]; u[0] = bf_hi(pm); u[9] = bf_lo(nx);
#pragma unroll
              for (int e = 0; e < 4; ++e) { u[1 + 2 * e] = bf_lo(d[e]); u[2 + 2 * e] = bf_hi(d[e]); }
              float r[8];
#pragma unroll
              for (int e = 0; e < 8; ++e) r[e] = cb + w0 * u[e] + w1 * u[e + 1] + w2 * u[e + 2];
              o.x = pk2(r[0], r[1]); o.y = pk2(r[2], r[3]); o.z = pk2(r[4], r[5]); o.w = pk2(r[6], r[7]); }
          *(LAS u32x4*)(lds + zn * HY_ZSTR + t8 * 2) = o; } }
    __syncthreads();
    const unsigned abase = ((n & 1) ? (unsigned)(HY_C1 - 2) : (unsigned)HY_C0) + 2u * (unsigned)(2048 - n + 8 * kg);
    const int b = 16 * bg + n;
#define HY_FRAG(e) ({ const LAS unsigned* fp_ = (const LAS unsigned*)(lds + (abase - 32 * (e))); u32x4 f_; f_.x = fp_[0]; f_.y = fp_[1]; f_.z = fp_[2]; f_.w = fp_[3]; __builtin_bit_cast(bf16x8, f_); })
#pragma unroll 1
    for (int order = 0; order < 2; ++order) {
        const int fg = 512 * (order + 1) + c;
        hy_dma_rows(p, lds, fg, bg, w, lane);
        const float skip = p.hy_skip[order * 512 + c];
        const float w0 = p.hy_conv_w[fg], w1 = p.hy_conv_w[1536 + fg], w2 = p.hy_conv_w[3072 + fg], cb = p.hy_conv_b[fg];
        bf16_t* dst = (bf16_t*)((unsigned char*)p.out + OUT_HYT) + ((size_t)(b < NBATCH ? b : 0) * 32 * 512 + c) * 64;
        u32x2 held[HY_NMI];
        const LAS unsigned char* zrow = lds + n * HY_ZSTR + kg * 16;
#pragma unroll
        for (int pass = 0; pass < HY_NP; ++pass) {
            f32x4 acc[HY_NMI]; bf16x8 ring[HY_NMI];
            const int E = 8 * HY_NMI * pass + HY_NMI * w;
#pragma unroll
            for (int mi = 0; mi < HY_NMI; ++mi) { acc[mi] = (f32x4){0.f, 0.f, 0.f, 0.f}; ring[mi] = HY_FRAG(E + mi); }
            bf16x8 bcur = *(const LAS bf16x8*)(zrow);
#pragma unroll 1
            for (int kb = 0; kb < 128 / HY_NMI; ++kb) {
#pragma unroll
                for (int kk = 0; kk < HY_NMI / 2; ++kk) {
                    const int ks = kb * (HY_NMI / 2) + kk;
                    const int kn = ks < 63 ? ks + 1 : 63;
                    const bf16x8 bnext = *(const LAS bf16x8*)(zrow + kn * 64);
                    acc[HY_NMI - 2] = __builtin_amdgcn_mfma_f32_16x16x32_bf16(ring[(HY_NMI - 2 - 2 * kk) & (HY_NMI - 1)], bcur, acc[HY_NMI - 2], 0, 0, 0);
                    acc[HY_NMI - 1] = __builtin_amdgcn_mfma_f32_16x16x32_bf16(ring[(HY_NMI - 1 - 2 * kk) & (HY_NMI - 1)], bcur, acc[HY_NMI - 1], 0, 0, 0);
                    asm volatile("" : "+v"(acc[HY_NMI - 2]), "+v"(acc[HY_NMI - 1]));
                    ring[(-2 * kk - 2) & (HY_NMI - 1)] = HY_FRAG(E - 2 * kn); ring[(-2 * kk - 1) & (HY_NMI - 1)] = HY_FRAG(E - 2 * kn + 1);
#pragma unroll
                    for (int mi = 2; mi < HY_NMI - 2; ++mi) acc[mi] = __builtin_amdgcn_mfma_f32_16x16x32_bf16(ring[(mi - 2 * kk) & (HY_NMI - 1)], bcur, acc[mi], 0, 0, 0);
                    acc[0] = __builtin_amdgcn_mfma_f32_16x16x32_bf16(ring[(0 - 2 * kk) & (HY_NMI - 1)], bcur, acc[0], 0, 0, 0);
                    acc[1] = __builtin_amdgcn_mfma_f32_16x16x32_bf16(ring[(1 - 2 * kk) & (HY_NMI - 1)], bcur, acc[1], 0, 0, 0);
                    bcur = bnext;
                }
            }
            if (pass == 0) { asm volatile("s_waitcnt vmcnt(0)" ::: "memory"); __syncthreads(); }
            u32x2 res[HY_NMI];
#pragma unroll
            for (int mi = 0; mi < HY_NMI; ++mi) {
                const int t = 128 * HY_NMI * pass + 16 * HY_NMI * w + 16 * mi + 4 * kg;
                const u32x2 zz = *(const LAS u32x2*)(lds + n * HY_ZSTR + t * 2);
                const LAS unsigned char* gp = lds + HY_GS + n * HY_ZSTR + t * 2;
                const u32x2 d = *(const LAS u32x2*)gp; unsigned pm = *(const LAS unsigned*)(gp - 4), nx = *(const LAS unsigned*)(gp + 8);
                pm = t > 0 ? pm : 0u; nx = (t + 4 < SEQ) ? nx : 0u;
                const float um = bf_hi(pm), up = bf_lo(nx), u0 = bf_lo(d.x), u1 = bf_hi(d.x), u2 = bf_lo(d.y), u3 = bf_hi(d.y);
                float g0 = cb + w0 * um + w1 * u0 + w2 * u1, g1 = cb + w0 * u0 + w1 * u1 + w2 * u2, g2 = cb + w0 * u1 + w1 * u2 + w2 * u3, g3 = cb + w0 * u2 + w1 * u3 + w2 * up;
                const float gm = (b < NBATCH) ? 1.f : 0.f;
                res[mi].x = pk2(gm * g0 * (acc[mi][0] + skip * bf_lo(zz.x)), gm * g1 * (acc[mi][1] + skip * bf_hi(zz.x)));
                res[mi].y = pk2(gm * g2 * (acc[mi][2] + skip * bf_lo(zz.y)), gm * g3 * (acc[mi][3] + skip * bf_hi(zz.y)));
            }
            if (order == 1 && b < NBATCH) {
#pragma unroll
                for (int mi = 0; mi < HY_NMI; ++mi) { const int t = 128 * HY_NMI * pass + 16 * HY_NMI * w + 16 * mi + 4 * kg; *(u32x2*)(dst + (size_t)(t >> 6) * (512 * 64) + (t & 63)) = res[mi]; }
            }
            if (pass + 1 < HY_NP) {
#pragma unroll
                for (int mi = 0; mi < HY_NMI; ++mi) held[mi] = res[mi];
            } else if (order == 0) {
                __syncthreads();
#pragma unroll
                for (int mi = 0; mi < HY_NMI; ++mi) { const int t0 = 16 * HY_NMI * w + 16 * mi + 4 * kg;
                    if (HY_NP == 2) *(LAS u32x2*)(lds + n * HY_ZSTR + t0 * 2) = held[mi];
                    *(LAS u32x2*)(lds + n * HY_ZSTR + (128 * HY_NMI * (HY_NP - 1) + t0) * 2) = res[mi]; }
                hy_load_filter(p, lds, 1, c, tid);
                __syncthreads();
            }
        }
    }
#undef HY_FRAG
    __syncthreads();
}

constexpr int MX_STR = 144, MX_T2 = 512 * MX_STR, MX_STR2 = 1032, MX_SST = MX_T2 + 64 * MX_STR2, MX_ITEMS = NTOK / 64;
static_assert(MX_SST % 16 == 0 && MX_SST + 64 * 8 * 4 <= LDS_BAR_OFF, "mix LDS map");
DI void mix_item(const Params& p, LAS unsigned char* lds, int item) {
    const int tid = threadIdx.x, lane = tid & 63, w = __builtin_amdgcn_readfirstlane(tid >> 6);
    const int tok0 = item * 64;
    const bf16_t* hyt = (const bf16_t*)((const unsigned char*)p.out + OUT_HYT);
    u32x4 hv[8];
#pragma unroll
    for (int it = 0; it < 8; ++it) { const int id = it * 512 + tid; hv[it] = *(const u32x4*)(hyt + ((size_t)item * 512 + (id >> 3)) * 64 + (id & 7) * 8); }
    bf16_t* mixed = (bf16_t*)(p.ws + WS_XB);
    const bf16_t* oacc = (const bf16_t*)((const unsigned char*)p.out + OUT_OACC);
    const float* lb = (const float*)(p.ws + WS_L);
    float av[8][8];
    { const size_t hoff = ((size_t)((tok0 >> 11) * 8 + w) * SEQ + (tok0 & (SEQ - 1))) * 64 + lane * 8;
      LAS float* sst = (LAS float*)(lds + MX_SST);
#pragma unroll
      for (int pb = 0; pb < 2; ++pb) {
          u32x4 d[4][3]; float lv[4][3];
#pragma unroll
          for (int q = 0; q < 4; ++q) { const int ps = 4 * pb + q;
#pragma unroll
              for (int br = 0; br < 3; ++br) { d[q][br] = *(const u32x4*)(oacc + (size_t)br * NTOK * 512 + hoff + ps * 512); lv[q][br] = lb[((size_t)br * NTOK + tok0 + 8 * ps + (lane >> 3)) * 8 + w]; } }
#pragma unroll
          for (int q = 0; q < 4; ++q) { const int ps = 4 * pb + q; const float il = 1.0f / (lv[q][0] + lv[q][1] + lv[q][2]); float ss = 0.f;
#pragma unroll
              for (int e2 = 0; e2 < 4; ++e2) { av[ps][2 * e2] = (bf_lo(d[q][0][e2]) + bf_lo(d[q][1][e2]) + bf_lo(d[q][2][e2])) * il; av[ps][2 * e2 + 1] = (bf_hi(d[q][0][e2]) + bf_hi(d[q][1][e2]) + bf_hi(d[q][2][e2])) * il; }
#pragma unroll
              for (int e2 = 0; e2 < 8; ++e2) ss += av[ps][e2] * av[ps][e2];
              ss += __shfl_xor(ss, 1); ss += __shfl_xor(ss, 2); ss += __shfl_xor(ss, 4);
              if ((lane & 7) == 0) sst[(8 * ps + (lane >> 3)) * 8 + w] = ss; }
      } }
#pragma unroll
    for (int it = 0; it < 8; ++it) { const int id = it * 512 + tid; *(LAS u32x4*)(lds + (id >> 3) * MX_STR + (id & 7) * 16) = hv[it]; }
    __syncthreads();
    { const LAS float* sst = (const LAS float*)(lds + MX_SST);
      bf16_t* mrow = mixed + (((size_t)(tok0 >> 8) * 16 + w) * 256 + (tok0 & 255)) * 64 + lane * 8;
#pragma unroll
      for (int ps = 0; ps < 8; ++ps) { const f32x4 s0 = *(const LAS f32x4*)(sst + (8 * ps + (lane >> 3)) * 8), s1 = *(const LAS f32x4*)(sst + (8 * ps + (lane >> 3)) * 8 + 4);
          const float tot = ((s0[0] + s0[1]) + (s0[2] + s0[3])) + ((s1[0] + s1[1]) + (s1[2] + s1[3]));
          const float rs = __builtin_amdgcn_rsqf(tot * (1.0f / 512.0f) + EPS);
          u32x4 o; o.x = pk2(av[ps][0] * rs, av[ps][1] * rs); o.y = pk2(av[ps][2] * rs, av[ps][3] * rs); o.z = pk2(av[ps][4] * rs, av[ps][5] * rs); o.w = pk2(av[ps][6] * rs, av[ps][7] * rs);
          *(u32x4*)(mrow + ps * 512) = o; } }
    { const int g = lane >> 4, l = lane & 15;
      const LAS unsigned char* rp = lds + (64 * w + (l >> 2)) * MX_STR + (16 * g + 4 * (l & 3)) * 2;
      LAS unsigned char* wp = lds + MX_T2 + lane * MX_STR2 + 64 * w * 2;
#pragma unroll
      for (int i = 0; i < 16; ++i) { const s16x4 v = __builtin_amdgcn_ds_read_tr16_b64_v4i16((LAS s16x4*)(rp + i * 4 * MX_STR)); *(LAS s16x4*)(wp + i * 8) = v; } }
    __syncthreads();
#pragma unroll 4
    for (int tk = 0; tk < 8; ++tk) {
        const int tl = 8 * w + tk; const size_t tok = (size_t)tok0 + tl;
        const u32x2 d0 = *(const LAS u32x2*)(lds + MX_T2 + tl * MX_STR2 + lane * 16), d1 = *(const LAS u32x2*)(lds + MX_T2 + tl * MX_STR2 + lane * 16 + 8);
        float v[8]; v[0] = bf_lo(d0.x); v[1] = bf_hi(d0.x); v[2] = bf_lo(d0.y); v[3] = bf_hi(d0.y); v[4] = bf_lo(d1.x); v[5] = bf_hi(d1.x); v[6] = bf_lo(d1.y); v[7] = bf_hi(d1.y);
        float ss = 0.f;
#pragma unroll
        for (int e = 0; e < 8; ++e) ss += v[e] * v[e];
        ss = wave_sum(ss); const float rs = __builtin_amdgcn_rsqf(ss * (1.0f / 512.0f) + EPS);
        u32x4 o; o.x = pk2(v[0] * rs, v[1] * rs); o.y = pk2(v[2] * rs, v[3] * rs); o.z = pk2(v[4] * rs, v[5] * rs); o.w = pk2(v[6] * rs, v[7] * rs);
        *(u32x4*)(mixed + (((tok >> 8) * 16 + 8 + (lane >> 3)) * 256 + (tok & 255)) * 64 + (lane & 7) * 8) = o;
    }
    __syncthreads();
}

#ifndef GEMM_SP2
#define GEMM_SP2 true
#endif
#ifndef GEMM_ALIGN
#define GEMM_ALIGN true
#endif
#ifndef REP_P0
#define REP_P0 1
#endif
#ifndef REP_P3
#define REP_P3 1
#endif
#ifndef REP_SYNC
#define REP_SYNC 1
#endif
#ifndef REP_HY
#define REP_HY 1
#endif
#ifndef REP_AT
#define REP_AT 1
#endif
#ifndef REP_UP
#define REP_UP 1
#endif
__global__ void __launch_bounds__(512, 2) fwd_kernel(Params p) {
    extern __shared__ __attribute__((aligned(16))) unsigned char lds_raw[];
    LAS unsigned char* lds = (LAS unsigned char*)lds_raw;
    const int G = gridDim.x, bid = blockIdx.x;
    const int lo = p.ph_lo, hi = p.ph_hi;
    cg::grid_group grid = cg::this_grid();
    if (hi > 1000) grid.sync();
    if (threadIdx.x < 4) ((LAS unsigned*)(lds + LDS_BAR_OFF))[threadIdx.x] = 0u;
    __syncthreads();
    XcdBarrier xbar; xbar.bar = (unsigned*)(p.ws + WS_BAR); xbar.x = 0; xbar.st = (volatile LAS unsigned*)(lds + LDS_BAR_OFF);
    if (hi - lo > 1) xbar = xcd_barrier_post((unsigned*)(p.ws + WS_BAR), (volatile LAS unsigned*)(lds + LDS_BAR_OFF));
#define IN(k) (lo <= (k) && (k) < hi)
#define SEAM(k) do { if (IN(k) && IN((k) + 1)) for (int rs_ = 0; rs_ < REP_SYNC; ++rs_) xcd_barrier(xbar); } while (0)
    bf16_t* xb = (bf16_t*)(p.ws + WS_XB);
    if (IN(0)) for (int rep = 0; rep < REP_P0; ++rep) p0_prep(p, lds, G, bid);
    SEAM(0);
    if (IN(1)) {
        { pg8::Gemm g{xb, (const bf16_t*)(p.ws + WS_WIN), NTOK, 1536, DM}; pg8::StaticOrder S; S.init(NTOK, 1536, G, bid);
          EpiQKV E{(bf16_t*)(p.ws + WS_Q), (const float*)(p.ws + WS_RSTD1), p.q_norm, p.k_norm, (const f32x2*)(p.ws + WS_CS)};
          pg8::gemm_phase<EpiQKV, pg8::StaticOrder, GEMM_ALIGN, GEMM_SP2>(lds, g, S, E); }
        { pg8::Gemm g{(const bf16_t*)(p.ws + WS_WIN) + (size_t)1536 * DM, xb, 1536, NTOK, DM}; pg8::StaticOrder S; S.init(1536, NTOK, G, (G % 16 == 0) ? (bid + G / 2) % G : bid);
          EpiUT E{(bf16_t*)(p.ws + WS_UT), (const float*)(p.ws + WS_RSTD1)};
          pg8::gemm_phase<EpiUT, pg8::StaticOrder, GEMM_ALIGN, GEMM_SP2>(lds, g, S, E); }
    }
    SEAM(1);
    if (IN(2)) {
#pragma unroll 1
        for (int ph = 0; ph < 2; ++ph) {
            if (ph == ((bid & 1) ? 0 : 1)) {
                int ln_ = threadIdx.x & 63; asm volatile("" : "+v"(ln_));
                float gq = fabsf(p.q_norm[ln_]), gk = fabsf(p.k_norm[ln_]);
#pragma unroll
                for (int s = 1; s < 64; s <<= 1) { gq = fmaxf(gq, __shfl_xor(gq, s)); gk = fmaxf(gk, __shfl_xor(gk, s)); }
                const float Mb = 8.0f * gq * gk * 1.4426950408889634f;
                for (int rep = 0; rep < REP_AT; ++rep) attn_phase(p, lds, G, bid, Mb);
            }
            if (ph == 0) { for (int rep = 0; rep < REP_HY; ++rep) for (int it = bid; it < HY_ITEMS; it += G) hyena_item(p, lds, it); }
        }
    }
    SEAM(2);
    if (IN(3)) { for (int rep = 0; rep < REP_P3; ++rep) for (int it = bid; it < MX_ITEMS; it += G) mix_item(p, lds, it); }
    SEAM(3);
    if (IN(4)) { pg8::Gemm g{xb, (const bf16_t*)(p.ws + WS_WOUT), NTOK, DM, DM}; pg8::StaticOrder S; S.init(NTOK, DM, G, bid);
        EpiH E{p.x_prompt, p.x_sample, p.out, (bf16_t*)(p.ws + WS_HB), (float*)(p.ws + WS_ROWSQ)};
        pg8::gemm_phase<EpiH, pg8::StaticOrder, GEMM_ALIGN, GEMM_SP2>(lds, g, S, E); }
    SEAM(4);
    if (IN(5)) for (int rep = 0; rep < REP_UP; ++rep) { pg8::Gemm g{(const bf16_t*)(p.ws + WS_HB), (const bf16_t*)(p.ws + WS_WUP), NTOK, DFF, DM}; pg8::StaticOrder S; S.init(NTOK, DFF, G, bid);
        EpiUp E{(bf16_t*)(p.ws + WS_A)};
        pg8::gemm_phase<EpiUp, pg8::StaticOrder, GEMM_ALIGN, GEMM_SP2>(lds, g, S, E); }
    SEAM(5);
    if (IN(6)) { pg8::Gemm g{(const bf16_t*)(p.ws + WS_A), (const bf16_t*)(p.ws + WS_WDN), NTOK, DM, DFF}; pg8::StaticOrder S; S.init(NTOK, DM, G, bid);
        EpiDown E{p.out, (const float*)(p.ws + WS_ROWSQ)};
        pg8::gemm_phase<EpiDown, pg8::StaticOrder, GEMM_ALIGN, GEMM_SP2>(lds, g, S, E); }
#undef IN
#undef SEAM
}

#ifndef N_LAUNCH_MODE
#define N_LAUNCH_MODE 1
#endif
extern "C" void kernel_launch(void* const* d_in, const int* in_sizes, int n_in, void* d_out, int out_size, void* d_ws, size_t ws_size, hipStream_t stream) {
    static int grid = 0;
    if (grid == 0) {
        if (n_in != 23 || ws_size < WS_TOTAL) { fprintf(stderr, "kernel_launch: unexpected n_in %d / ws %zu (need %zu)\n", n_in, ws_size, (size_t)WS_TOTAL); grid = -1; return; }
        int dev = 0, cus = 0, per_cu = 0;
        (void)hipGetDevice(&dev); (void)hipDeviceGetAttribute(&cus, hipDeviceAttributeMultiprocessorCount, dev);
        if (hipFuncSetAttribute((const void*)fwd_kernel, hipFuncAttributeMaxDynamicSharedMemorySize, LDS_BYTES) != hipSuccess) { fprintf(stderr, "kernel_launch: hipFuncSetAttribute failed\n"); grid = -1; return; }
        if (hipOccupancyMaxActiveBlocksPerMultiprocessor(&per_cu, (const void*)fwd_kernel, 512, LDS_BYTES) != hipSuccess || per_cu < 1) { fprintf(stderr, "kernel_launch: occupancy query gave %d\n", per_cu); per_cu = 1; }
        (void)hipGetLastError();
        grid = cus * per_cu;
    }
    if (grid < 0) return;
    Params p{};
    const float** pp = (const float**)&p;
    for (int i = 0; i < 23; ++i) pp[i] = (const float*)d_in[i];
    p.out = (float*)d_out; p.ws = (unsigned char*)d_ws;
#if N_LAUNCH_MODE == 1
    if (hipMemsetAsync((unsigned char*)d_ws + WS_BAR, 0, XCD_BAR_WORDS * 4, stream) != hipSuccess) { fprintf(stderr, "kernel_launch: memset of barrier words failed\n"); return; }
    p.ph_lo = 0; p.ph_hi = 7;
    void* args[] = {&p};
    hipError_t e = hipLaunchCooperativeKernel((const void*)fwd_kernel, dim3(grid), dim3(512), args, LDS_BYTES, stream);
    if (e != hipSuccess) fprintf(stderr, "cooperative launch failed: %s (grid %d)\n", hipGetErrorString(e), grid);
#else
    for (int k = 0; k < 7; ++k) { p.ph_lo = k; p.ph_hi = k + 1; fwd_kernel<<<dim3(grid), dim3(512), LDS_BYTES, stream>>>(p); }
#endif
}
```

```cpp
#include <hip/hip_runtime.h>
#include <hip/hip_cooperative_groups.h>
#include <cstdio>
#include <cstdint>
namespace cg = cooperative_groups;
namespace pg8 {
#define PG8_LAS __attribute__((address_space(3)))
typedef unsigned short bf16_t;
typedef short bf16x8 __attribute__((ext_vector_type(8)));
typedef float f32x4 __attribute__((ext_vector_type(4)));
typedef unsigned u32x4 __attribute__((ext_vector_type(4)));
constexpr int BM = 256, BK = 64, HALF = 128, HTB = HALF * BK * 2  , STAGE_BYTES = 8 * HTB, NXCD = 8, WGM = 8;

__host__ __device__ __forceinline__ int lds_byte(int r, int c) { const int st = (r >> 4) * 2 + (c >> 5), rr = r & 15, cc = c & 31, ob = rr * 64 + cc * 2; return st * 1024 + (ob ^ (((ob >> 9) & 1) << 5)); }
__host__ __device__ __forceinline__ void stage_rc(int b, int& R, int& C) { const int st = b / 1024, sb = b % 1024, swz = sb ^ (((sb >> 9) & 1) << 5); R = (st >> 1) * 16 + swz / 64; C = (st & 1) * 32 + (swz % 64) / 2; }
__host__ __device__ __forceinline__ int perm32(int rho) { const int n = rho >> 4, i = rho & 15; return 8 * (i >> 2) + 4 * n + (i & 3); }

struct Unit { int pm, pn; };
struct Gemm { const bf16_t* A; const bf16_t* Bt; int M, N, K; };

struct StaticOrder {
    int nM, nN, nwg, G, c;
    __host__ __device__ void init(int M, int N, int G_, int c_) { nM = M / BM; nN = N / BM; nwg = nM * nN; G = G_; c = c_; }
    __host__ __device__ bool next(int i, Unit& u) const {
        const long L = (long)i * G + c; if (L >= nwg) return false;
        int wgid = (int)L; { const int q = nwg / NXCD, r = nwg % NXCD, xcd = wgid % NXCD, off = wgid / NXCD; wgid = (xcd < r ? xcd * (q + 1) : r * (q + 1) + (xcd - r) * q) + off; }
        const int nig = WGM * nN, gid = wgid / nig, fm = gid * WGM, gsz = (nM - fm) < WGM ? (nM - fm) : WGM;
        u.pm = fm + ((wgid % nig) % gsz); u.pn = (wgid % nig) / gsz; return true;
    }
    __device__ __forceinline__ void a_ready(const Unit&) const {}
    __device__ __forceinline__ void done(const Unit&) const {}
};


template <class Epi, class Sched, bool ALIGN_EPI = false, bool SP2 = false>
__device__ __forceinline__ void gemm_phase(PG8_LAS unsigned char* lds, const Gemm g, const Sched& S, const Epi& E) {
    const int tid = threadIdx.x, wid = __builtin_amdgcn_readfirstlane(tid >> 6), lane = tid & 63, wr = wid >> 2, wc = wid & 3, fr = lane & 15, fq = lane >> 4;
    const int K = g.K, nt = K / BK;
    unsigned voffA[2], voffB[2];
#pragma unroll
    for (int i = 0; i < 2; ++i) { int R, C; stage_rc(tid * 16 + i * 8192, R, C); const int Rb = Epi::PERM ? ((R & ~31) + perm32(R & 31)) : R;
        voffA[i] = Epi::ABLK ? (unsigned)(R * 64 + C) * 2u : (unsigned)(R * K + C) * 2u; voffB[i] = (unsigned)(Rb * K + C) * 2u; }
    const size_t kstep = (size_t)(BK * 2);
    const size_t hstep = (size_t)HALF * K * 2;
    const size_t tstep = 2 * hstep;
    const size_t kstepA = Epi::ABLK ? (size_t)(256 * 64 * 2) : kstep, hstepA = Epi::ABLK ? (size_t)(128 * 64 * 2) : hstep, tstepA = Epi::ABLK ? (size_t)(K / 64) * (256 * 64 * 2) : tstep;
    const unsigned ldsw = (unsigned)wid * 1024u;
    const int aoff = lds_byte(wr * 64 + fr, fq * 8), boff = lds_byte(wc * 32 + fr, fq * 8);
#define PG8_SA(b, h) (((b) * 2 + (h)) * HTB)
#define PG8_SB(b, h) ((4 + (b) * 2 + (h)) * HTB)
#define PG8_STAGE(bufoff, gbase, voff) do { _Pragma("unroll") for (int _i = 0; _i < 2; ++_i) \
        __builtin_amdgcn_global_load_lds((const unsigned*)((const char*)(gbase) + (voff)[_i]), (PG8_LAS unsigned*)(lds + (bufoff) + ldsw + _i * 8192), 16, 0, 0); } while (0)
#define PG8_LDA(dst, b, h) do { _Pragma("unroll") for (int m = 0; m < 4; ++m) _Pragma("unroll") for (int k = 0; k < 2; ++k) dst[m][k] = *(const PG8_LAS bf16x8*)(lds + PG8_SA(b, h) + aoff + m * 2048 + k * 1024); } while (0)
#define PG8_LDB(dst, b, h) do { _Pragma("unroll") for (int n = 0; n < 2; ++n) _Pragma("unroll") for (int k = 0; k < 2; ++k) dst[n][k] = *(const PG8_LAS bf16x8*)(lds + PG8_SB(b, h) + boff + n * 2048 + k * 1024); } while (0)
#define PG8_MMA(ai, bj, At, Bt) do { __builtin_amdgcn_s_setprio(1); _Pragma("unroll") for (int m = 0; m < 4; ++m) _Pragma("unroll") for (int n = 0; n < 2; ++n) _Pragma("unroll") for (int k = 0; k < 2; ++k) \
        acc[ai][bj][m][n] = __builtin_amdgcn_mfma_f32_16x16x32_bf16(Bt[n][k], At[m][k], acc[ai][bj][m][n], 0, 0, 0); __builtin_amdgcn_s_setprio(0); } while (0)
#define PG8_WAIT_V(n) asm volatile("s_waitcnt vmcnt(" #n ")" ::: "memory")
#define PG8_WAIT_L(n) asm volatile("s_waitcnt lgkmcnt(" #n ")" ::: "memory")
#define PG8_BAR __builtin_amdgcn_s_barrier()
#define PG8_SCHED __builtin_amdgcn_sched_barrier(0)
    Unit cur, nxt; int ui = 0;
    if (!S.next(0, cur)) return;
    f32x4 acc[2][2][4][2];
#pragma unroll
    for (int a = 0; a < 2; ++a)
#pragma unroll
        for (int b = 0; b < 2; ++b)
#pragma unroll
            for (int m = 0; m < 4; ++m)
#pragma unroll
                for (int n = 0; n < 2; ++n) acc[a][b][m][n] = (f32x4){0.f, 0.f, 0.f, 0.f};
    bf16x8 At[4][2], B0[2][2], B1[2][2];
    const char* cA = (const char*)g.A + (size_t)cur.pm * tstepA; const char* cB = (const char*)g.Bt + (size_t)cur.pn * tstep;
    S.a_ready(cur);
    if constexpr (SP2) {
        PG8_STAGE(PG8_SB(0, 0), cB, voffB); PG8_STAGE(PG8_SB(0, 1), cB + hstep, voffB); PG8_STAGE(PG8_SA(0, 0), cA, voffA); PG8_STAGE(PG8_SA(0, 1), cA + hstepA, voffA);
        if (wr == 1) PG8_BAR;
        PG8_WAIT_V(2); PG8_BAR;
        PG8_STAGE(PG8_SB(1, 0), cB + kstep, voffB); PG8_STAGE(PG8_SA(1, 0), cA + kstepA, voffA); PG8_STAGE(PG8_SB(1, 1), cB + hstep + kstep, voffB);
        PG8_WAIT_V(6); PG8_BAR;
    } else {
        PG8_STAGE(PG8_SB(0, 0), cB, voffB); PG8_STAGE(PG8_SA(0, 0), cA, voffA); PG8_STAGE(PG8_SB(0, 1), cB + hstep, voffB); PG8_STAGE(PG8_SA(0, 1), cA + hstepA, voffA);
        if (wr == 1) PG8_BAR;
        PG8_WAIT_V(4); PG8_BAR;
        PG8_STAGE(PG8_SB(1, 0), cB + kstep, voffB); PG8_STAGE(PG8_SA(1, 0), cA + kstepA, voffA); PG8_STAGE(PG8_SB(1, 1), cB + hstep + kstep, voffB);
        PG8_WAIT_V(6); PG8_BAR;
    }
    for (;;) {
        const bool has_next = S.next(ui + 1, nxt);
        const char* nA = has_next ? (const char*)g.A + (size_t)nxt.pm * tstepA : cA; const char* nB = has_next ? (const char*)g.Bt + (size_t)nxt.pn * tstep : cB;
        for (int t = 0; t < nt; t += 2) {
            const bool last = (t == nt - 2);
            const char* a1 = cA + (size_t)(t + 1) * kstepA;
            const char* a2 = last ? nA : cA + (size_t)(t + 2) * kstepA; const char* b2 = last ? nB : cB + (size_t)(t + 2) * kstep;
            const char* a3 = a2 + kstepA; const char* b3 = b2 + kstep;
            if (last && has_next) S.a_ready(nxt);
            if constexpr (SP2) {
            PG8_LDB(B0, 0, 0); PG8_LDB(B1, 0, 1); PG8_SCHED; PG8_LDA(At, 0, 0); PG8_STAGE(PG8_SA(1, 1), a1 + hstepA, voffA);
            PG8_WAIT_V(8); PG8_WAIT_L(0); PG8_BAR; PG8_MMA(0, 0, At, B0); PG8_MMA(0, 1, At, B1); PG8_BAR; PG8_SCHED;
            PG8_LDA(At, 0, 1); PG8_STAGE(PG8_SB(0, 0), b2, voffB); PG8_STAGE(PG8_SB(0, 1), b2 + hstep, voffB); PG8_STAGE(PG8_SA(0, 0), a2, voffA);
            PG8_WAIT_V(8); PG8_WAIT_L(0); PG8_BAR; PG8_MMA(1, 0, At, B0); PG8_MMA(1, 1, At, B1); PG8_BAR; PG8_SCHED;
            PG8_LDB(B0, 1, 0); PG8_LDB(B1, 1, 1); PG8_SCHED; PG8_LDA(At, 1, 0); PG8_STAGE(PG8_SA(0, 1), a2 + hstepA, voffA);
            PG8_WAIT_V(8); PG8_WAIT_L(0); PG8_BAR; PG8_MMA(0, 0, At, B0); PG8_MMA(0, 1, At, B1); PG8_BAR; PG8_SCHED;
            PG8_LDA(At, 1, 1); PG8_STAGE(PG8_SB(1, 0), b3, voffB); PG8_STAGE(PG8_SB(1, 1), b3 + hstep, voffB); PG8_STAGE(PG8_SA(1, 0), a3, voffA);
            PG8_WAIT_V(8); PG8_WAIT_L(0); PG8_BAR; PG8_MMA(1, 0, At, B0); PG8_MMA(1, 1, At, B1); PG8_BAR; PG8_SCHED;
            } else {
            PG8_LDB(B0, 0, 0); PG8_SCHED; PG8_LDA(At, 0, 0); PG8_STAGE(PG8_SA(1, 1), a1 + hstepA, voffA);
            PG8_WAIT_L(8); PG8_BAR; PG8_WAIT_L(0); PG8_MMA(0, 0, At, B0); PG8_BAR; PG8_SCHED;
            PG8_LDB(B1, 0, 1); PG8_STAGE(PG8_SB(0, 0), b2, voffB);
            PG8_BAR; PG8_WAIT_L(0); PG8_MMA(0, 1, At, B1); PG8_BAR;
            PG8_LDA(At, 0, 1); PG8_STAGE(PG8_SA(0, 0), a2, voffA);
            PG8_BAR; PG8_WAIT_L(0); PG8_MMA(1, 0, At, B0); PG8_BAR; PG8_SCHED;
            PG8_STAGE(PG8_SB(0, 1), b2 + hstep, voffB);
            PG8_WAIT_V(6); PG8_BAR; PG8_MMA(1, 1, At, B1); PG8_BAR;
            PG8_LDB(B0, 1, 0); PG8_SCHED; PG8_LDA(At, 1, 0); PG8_STAGE(PG8_SA(0, 1), a2 + hstepA, voffA);
            PG8_WAIT_L(8); PG8_BAR; PG8_WAIT_L(0); PG8_MMA(0, 0, At, B0); PG8_BAR; PG8_SCHED;
            PG8_LDB(B1, 1, 1); PG8_STAGE(PG8_SB(1, 0), b3, voffB);
            PG8_BAR; PG8_WAIT_L(0); PG8_MMA(0, 1, At, B1); PG8_BAR;
            PG8_LDA(At, 1, 1); PG8_STAGE(PG8_SA(1, 0), a3, voffA);
            PG8_BAR; PG8_WAIT_L(0); PG8_MMA(1, 0, At, B0); PG8_BAR; PG8_SCHED;
            PG8_STAGE(PG8_SB(1, 1), b3 + hstep, voffB);
            PG8_WAIT_V(6); PG8_BAR; PG8_MMA(1, 1, At, B1); PG8_BAR;
            }
        }
        if constexpr (ALIGN_EPI) { if (wr == 0) PG8_BAR; }
        if constexpr (!Epi::AFTER_DRAIN) { E(acc, cur, wr, wc, fr, fq); S.done(cur); }
        if (!has_next) break;
#pragma unroll
        for (int a = 0; a < 2; ++a)
#pragma unroll
            for (int b = 0; b < 2; ++b)
#pragma unroll
                for (int m = 0; m < 4; ++m)
#pragma unroll
                    for (int n = 0; n < 2; ++n) acc[a][b][m][n] = (f32x4){0.f, 0.f, 0.f, 0.f};
        cur = nxt; cA = nA; cB = nB; ++ui;
        if constexpr (ALIGN_EPI) { if (wr == 1) PG8_BAR; }
    }
    PG8_WAIT_V(0);
    if constexpr (!ALIGN_EPI) { if (wr == 0) PG8_BAR; }
    PG8_BAR;
    if constexpr (Epi::AFTER_DRAIN) { E.fused(acc, cur, wr, wc, fr, fq, lds, wid, lane); S.done(cur); }
#undef PG8_SA
#undef PG8_SB
#undef PG8_STAGE
#undef PG8_LDA
#undef PG8_LDB
#undef PG8_MMA
#undef PG8_WAIT_V
#undef PG8_WAIT_L
#undef PG8_BAR
#undef PG8_SCHED
}
}
#define LAS __attribute__((address_space(3)))
#include <hip/hip_runtime.h>
#include <cstdio>
#include <cstdint>
#include <cstdlib>
#include <vector>

#define XB_TMO      128
#define XB_XCNT(j)  (256  + 64 * (j))
#define XB_XSUB(j)  (1280 + 64 * (j))
#define XB_XGEN(j)  (2304 + 64 * (j))
#define XB_TOP      3328
#define XB_TOPGEN   3392
#define XCD_BAR_WORDS 3456
#define XB_SPIN_CAP (1u << 18)

__device__ __forceinline__ unsigned xb_ld(unsigned* p)              { return __hip_atomic_load(p, __ATOMIC_RELAXED, __HIP_MEMORY_SCOPE_AGENT); }
__device__ __forceinline__ unsigned xb_add(unsigned* p, unsigned v) { return __hip_atomic_fetch_add(p, v, __ATOMIC_RELAXED, __HIP_MEMORY_SCOPE_AGENT); }
__device__ __forceinline__ unsigned xb_xcc_id() { return (unsigned)__builtin_amdgcn_s_getreg((3 << 11) | 20) & 0xFu; }
#define XB_SPIN(cond, bar) do { unsigned _sp = 0; while (cond) { __builtin_amdgcn_s_sleep(1); \
    if ((++_sp & 255u) == 0u) { if (xb_ld(&(bar)[XB_TMO])) break; if (_sp > XB_SPIN_CAP) { atomicAdd(&(bar)[XB_TMO], 1u); break; } } } } while (0)

struct XcdBarrier {
    unsigned* bar; unsigned x;
    volatile LAS unsigned* st;
};

__device__ __forceinline__ XcdBarrier xcd_barrier_post(unsigned* bar, volatile LAS unsigned* st) {
    XcdBarrier b; b.bar = bar; b.x = xb_xcc_id(); b.st = st;
    if (threadIdx.x == 0) (void)xb_add(&bar[XB_XCNT(b.x)], 1u);
    return b;
}
__device__ __forceinline__ void xcd_barrier_complete(unsigned* bar, unsigned x, unsigned& nloc, unsigned& nx) {
    const unsigned G = gridDim.x * gridDim.y * gridDim.z;
    unsigned sum, cnt, mine, sp = 0u;
    for (;;) {
        sum = 0u; cnt = 0u; mine = 0u;
#pragma unroll
        for (unsigned j = 0; j < 16; ++j) { const unsigned c = xb_ld(&bar[XB_XCNT(j)]); sum += c; cnt += (c > 0u) ? 1u : 0u; mine = (j == x) ? c : mine; }
        if (sum == G) break;
        __builtin_amdgcn_s_sleep(1);
        if ((++sp & 255u) == 0u) { if (xb_ld(&bar[XB_TMO])) break; if (sp > XB_SPIN_CAP) { atomicAdd(&bar[XB_TMO], 1u); break; } }
    }
    nloc = mine > 0u ? mine : 1u; nx = cnt > 0u ? cnt : 1u;
}

__device__ __forceinline__ void xcd_barrier(const XcdBarrier& b) {
    asm volatile("s_waitcnt vmcnt(0)" ::: "memory");
    __syncthreads();
    if (threadIdx.x == 0) {
        unsigned* bar = b.bar;
        __builtin_amdgcn_s_waitcnt(0);
        unsigned nloc = b.st[0], nx = b.st[1];
        if (nloc == 0u) { xcd_barrier_complete(bar, b.x, nloc, nx); b.st[0] = nloc; b.st[1] = nx; }
        const unsigned old = xb_add(&bar[XB_XSUB(b.x)], 1u);
        const unsigned gen = old / nloc;
        if (old + 1u == (gen + 1u) * nloc) {
            __builtin_amdgcn_fence(__ATOMIC_RELEASE, "agent");
            asm volatile("s_waitcnt vmcnt(0)" ::: "memory");
            const unsigned og = xb_add(&bar[XB_TOP], 1u);
            const unsigned tg = og / nx;
            if (og + 1u == (tg + 1u) * nx) xb_add(&bar[XB_TOPGEN], 1u);
            else XB_SPIN(xb_ld(&bar[XB_TOPGEN]) == tg, bar);
            __builtin_amdgcn_fence(__ATOMIC_ACQUIRE, "agent");
            xb_add(&bar[XB_XGEN(b.x)], 1u);
            asm volatile("s_waitcnt vmcnt(0)" ::: "memory");
        } else {
            XB_SPIN(xb_ld(&bar[XB_XGEN(b.x)]) == gen, bar);
            __builtin_amdgcn_fence(__ATOMIC_ACQUIRE, "agent");
            asm volatile("s_waitcnt vmcnt(0)" ::: "memory");
        }
    }
    __syncthreads();
}


typedef unsigned short bf16_t;
typedef short bf16x8 __attribute__((ext_vector_type(8)));
typedef float f32x4 __attribute__((ext_vector_type(4)));
typedef float f32x2 __attribute__((ext_vector_type(2)));
typedef unsigned u32x4 __attribute__((ext_vector_type(4)));
typedef unsigned u32x2 __attribute__((ext_vector_type(2)));
typedef __bf16 bf16x2_t __attribute__((ext_vector_type(2)));
#define DI __device__ __forceinline__

constexpr int DM = 1024, NBATCH = 40, SEQ = 2048, NTOK = NBATCH * SEQ, NTOK_P = 32 * SEQ;
constexpr int AW = 512, HWID = 512, INW = 3072, DFF = 4096;
constexpr float EPS = 1e-6f;
constexpr float QSCALE = 0.18033688011112042f;
constexpr int LDS_BAR_OFF = 163808;
constexpr int LDS_BYTES = LDS_BAR_OFF + 16;

constexpr size_t WS_WIN = 0;
constexpr size_t WS_WOUT = WS_WIN + (size_t)3072 * 1024 * 2;
constexpr size_t WS_WUP = WS_WOUT + (size_t)1024 * 1024 * 2;
constexpr size_t WS_WDN = WS_WUP + (size_t)4096 * 1024 * 2;
constexpr size_t WS_R = WS_WDN + (size_t)1024 * 4096 * 2;
constexpr size_t WS_CS = WS_R + (size_t)2 * 512 * 4096 * 2;
constexpr size_t WS_RSTD1 = WS_CS + (size_t)2048 * 32 * 8;
constexpr size_t WS_ROWSQ = WS_RSTD1 + (size_t)NTOK * 4;
constexpr size_t WS_L = WS_ROWSQ + (size_t)NTOK * 4;
constexpr size_t WS_HB = WS_L + (size_t)3 * NTOK * 8 * 4;
constexpr size_t WS_A = WS_HB + (size_t)NTOK * 1024 * 2;
constexpr size_t WS_XB = WS_A;
constexpr size_t WS_Q = WS_XB + (size_t)NTOK * 1024 * 2;
constexpr size_t WS_K = WS_Q + (size_t)NTOK * 512 * 2;
constexpr size_t WS_V = WS_K + (size_t)NTOK * 512 * 2;
constexpr size_t WS_UT = WS_V + (size_t)NTOK * 512 * 2;
constexpr size_t WS_END = WS_UT + (size_t)1536 * NTOK * 2;
static_assert(WS_END - WS_A == (size_t)NTOK * 4096 * 2, "fbuf overlay");
constexpr size_t WS_BAR = WS_END;
constexpr size_t WS_TOTAL = WS_BAR + 16384;
constexpr size_t OUT_OACC = 0, OUT_HYT = (size_t)3 * NTOK * 512 * 2;

struct Params {
    const float *x_prompt, *x_sample, *mix_norm, *w_in, *q_norm, *k_norm, *hy_conv_w, *hy_conv_b,
        *flt_w1, *flt_b1, *flt_freq1, *flt_w2, *flt_b2, *flt_freq2, *flt_w3, *flt_b3, *hy_skip,
        *attn_out_norm, *hy_out_norm, *w_out, *ffn_norm, *w_up, *w_down;
    float* out; unsigned char* ws; int ph_lo, ph_hi;
};

DI unsigned pk2(float a, float b) { f32x2 v = {a, b}; bf16x2_t r = __builtin_convertvector(v, bf16x2_t); return __builtin_bit_cast(unsigned, r); }
DI float bf_lo(unsigned u) { return __uint_as_float(u << 16); }
DI float bf_hi(unsigned u) { return __uint_as_float(u & 0xffff0000u); }
DI float bf1(bf16_t b) { return __uint_as_float((unsigned)b << 16); }
DI float wave_sum(float v) { v += __shfl_xor(v, 1); v += __shfl_xor(v, 2); v += __shfl_xor(v, 4); v += __shfl_xor(v, 8); v += __shfl_xor(v, 16); v += __shfl_xor(v, 32); return v; }
DI const float* xrow(const Params& p, int row) { return row < NTOK_P ? p.x_prompt + (size_t)row * DM : p.x_sample + (size_t)(row - NTOK_P) * DM; }

using pg8::Unit;
struct EpiQKV {
    static constexpr bool PERM = true, AFTER_DRAIN = false, ABLK = false;
    bf16_t* qkv; const float* rstd1; const float *qn, *kn; const f32x2* cs;
    DI void operator()(const f32x4 (&acc)[2][2][4][2], const Unit& u, int wr, int wc, int fr, int fq) const {
        const int kind = u.pn >> 1;
        bf16_t* dst = qkv + (size_t)kind * ((size_t)NTOK * 512);
        const int fbase = (u.pn & 1) * 256 + wc * 64 + 8 * fq;
        f32x4 g[2][2];
        if (kind < 2) { const float* gn = kind == 0 ? qn : kn;
#pragma unroll
            for (int bj = 0; bj < 2; ++bj)
#pragma unroll
                for (int n = 0; n < 2; ++n) g[bj][n] = *(const f32x4*)(gn + 32 * bj + 8 * fq + 4 * n); }
#pragma unroll
        for (int ai = 0; ai < 2; ++ai)
#pragma unroll
            for (int m = 0; m < 4; ++m) {
                const int row = u.pm * 256 + ai * 128 + wr * 64 + m * 16 + fr;
                const float rs = rstd1[row];
                f32x4 v[2][2];
#pragma unroll
                for (int bj = 0; bj < 2; ++bj)
#pragma unroll
                    for (int n = 0; n < 2; ++n) v[bj][n] = acc[ai][bj][m][n] * rs;
                if (kind < 2) {
                    float ss = 0.f;
#pragma unroll
                    for (int bj = 0; bj < 2; ++bj)
#pragma unroll
                        for (int n = 0; n < 2; ++n) { const f32x4 x = v[bj][n]; ss += (x[0] * x[0] + x[1] * x[1]) + (x[2] * x[2] + x[3] * x[3]); }
                    ss += __shfl_xor(ss, 16); ss += __shfl_xor(ss, 32);
                    const float hr = __builtin_amdgcn_rsqf(ss * (1.0f / 64.0f) + EPS) * (kind == 0 ? QSCALE : 1.0f);
#pragma unroll
                    for (int bj = 0; bj < 2; ++bj)
#pragma unroll
                        for (int n = 0; n < 2; ++n) v[bj][n] = v[bj][n] * hr * g[bj][n];
                    const f32x2* c = cs + (size_t)(row & (SEQ - 1)) * 32 + 8 * fq;
#pragma unroll
                    for (int n = 0; n < 2; ++n) {
                        const f32x4 c01 = *(const f32x4*)(c + 4 * n), c23 = *(const f32x4*)(c + 4 * n + 2);
                        const float cc[4] = {c01[0], c01[2], c23[0], c23[2]}, sn[4] = {c01[1], c01[3], c23[1], c23[3]};
#pragma unroll
                        for (int j = 0; j < 4; ++j) { const float x1 = v[0][n][j], x2 = v[1][n][j]; v[0][n][j] = x1 * cc[j] - x2 * sn[j]; v[1][n][j] = x2 * cc[j] + x1 * sn[j]; }
                    }
                }
                bf16_t* rp = dst + ((size_t)((row >> 11) * 8 + (fbase >> 6)) * SEQ + (row & (SEQ - 1))) * 64 + (fbase & 63);
#pragma unroll
                for (int bj = 0; bj < 2; ++bj) { u32x4 w; w.x = pk2(v[bj][0][0], v[bj][0][1]); w.y = pk2(v[bj][0][2], v[bj][0][3]); w.z = pk2(v[bj][1][0], v[bj][1][1]); w.w = pk2(v[bj][1][2], v[bj][1][3]); *(u32x4*)(rp + 32 * bj) = w; }
            }
    }
};
struct EpiUT {
    static constexpr bool PERM = true, AFTER_DRAIN = false, ABLK = false;
    bf16_t* ut; const float* rstd1;
    DI void operator()(const f32x4 (&acc)[2][2][4][2], const Unit& u, int wr, int wc, int fr, int fq) const {
        const int col0 = u.pn * 256 + wc * 32 + 8 * fq;
        f32x4 rs[2][2];
#pragma unroll
        for (int bj = 0; bj < 2; ++bj)
#pragma unroll
            for (int n = 0; n < 2; ++n) rs[bj][n] = *(const f32x4*)(rstd1 + col0 + bj * 128 + n * 4);
#pragma unroll
        for (int ai = 0; ai < 2; ++ai)
#pragma unroll
            for (int m = 0; m < 4; ++m) {
                const int row = u.pm * 256 + ai * 128 + wr * 64 + m * 16 + fr;
                bf16_t* rp = ut + (size_t)row * NTOK + col0;
#pragma unroll
                for (int bj = 0; bj < 2; ++bj) { const f32x4 x0 = acc[ai][bj][m][0] * rs[bj][0], x1 = acc[ai][bj][m][1] * rs[bj][1];
                    u32x4 w; w.x = pk2(x0[0], x0[1]); w.y = pk2(x0[2], x0[3]); w.z = pk2(x1[0], x1[1]); w.w = pk2(x1[2], x1[3]); *(u32x4*)(rp + bj * 128) = w; }
            }
    }
};
struct EpiH {
    static constexpr bool PERM = true, AFTER_DRAIN = false, ABLK = true;
    const float *xp, *xs; float* out; bf16_t* hb; float* rowsq;
    DI void operator()(const f32x4 (&acc)[2][2][4][2], const Unit& u, int wr, int wc, int fr, int fq) const {
        const int col0 = u.pn * 256 + wc * 32 + 8 * fq;
#pragma unroll
        for (int ai = 0; ai < 2; ++ai)
#pragma unroll
            for (int m = 0; m < 4; ++m) {
                const int row = u.pm * 256 + ai * 128 + wr * 64 + m * 16 + fr;
                const float* xr = (row < NTOK_P ? xp + (size_t)row * DM : xs + (size_t)(row - NTOK_P) * DM) + col0;
                float ss = 0.f;
#pragma unroll
                for (int bj = 0; bj < 2; ++bj) {
                    const f32x4 h0 = *(const f32x4*)(xr + bj * 128) + acc[ai][bj][m][0], h1 = *(const f32x4*)(xr + bj * 128 + 4) + acc[ai][bj][m][1];
                    *(f32x4*)(out + (size_t)row * DM + col0 + bj * 128) = h0; *(f32x4*)(out + (size_t)row * DM + col0 + bj * 128 + 4) = h1;
                    u32x4 w; w.x = pk2(h0[0], h0[1]); w.y = pk2(h0[2], h0[3]); w.z = pk2(h1[0], h1[1]); w.w = pk2(h1[2], h1[3]); *(u32x4*)(hb + (((size_t)u.pm * (DM / 64) + (u.pn * 4 + bj * 2 + (wc >> 1))) * 256 + (row & 255)) * 64 + (wc & 1) * 32 + 8 * fq) = w;
                    ss += (h0[0] * h0[0] + h0[1] * h0[1]) + (h0[2] * h0[2] + h0[3] * h0[3]) + (h1[0] * h1[0] + h1[1] * h1[1]) + (h1[2] * h1[2] + h1[3] * h1[3]);
                }
                ss += __shfl_xor(ss, 16); ss += __shfl_xor(ss, 32);
                if (fq == 0) atomicAdd(rowsq + row, ss);
            }
    }
};
struct EpiUp {
    static constexpr bool PERM = true, AFTER_DRAIN = false, ABLK = true;
    bf16_t* f;
    DI void operator()(const f32x4 (&acc)[2][2][4][2], const Unit& u, int wr, int wc, int fr, int fq) const {
#pragma unroll
        for (int ai = 0; ai < 2; ++ai)
#pragma unroll
            for (int m = 0; m < 4; ++m) {
                const int r = ai * 128 + wr * 64 + m * 16 + fr;
#pragma unroll
                for (int bj = 0; bj < 2; ++bj) { f32x4 x0 = acc[ai][bj][m][0], x1 = acc[ai][bj][m][1];
#pragma unroll
                    for (int j = 0; j < 4; ++j) { const float r0 = fmaxf(x0[j], 0.f), r1 = fmaxf(x1[j], 0.f); x0[j] = r0 * r0; x1[j] = r1 * r1; }
                    const int kt = u.pn * 4 + bj * 2 + (wc >> 1);
                    bf16_t* rp = f + (((size_t)u.pm * (DFF / 64) + kt) * 256 + r) * 64 + (wc & 1) * 32 + 8 * fq;
                    u32x4 w; w.x = pk2(x0[0], x0[1]); w.y = pk2(x0[2], x0[3]); w.z = pk2(x1[0], x1[1]); w.w = pk2(x1[2], x1[3]); *(u32x4*)rp = w; }
            }
    }
};
struct EpiDown {
    static constexpr bool PERM = true, AFTER_DRAIN = false, ABLK = true;
    float* out; const float* rowsq;
    DI void operator()(const f32x4 (&acc)[2][2][4][2], const Unit& u, int wr, int wc, int fr, int fq) const {
        const int col0 = u.pn * 256 + wc * 32 + 8 * fq;
#pragma unroll
        for (int ai = 0; ai < 2; ++ai)
#pragma unroll
            for (int m = 0; m < 4; ++m) {
                const int row = u.pm * 256 + ai * 128 + wr * 64 + m * 16 + fr;
                const float r2 = 1.0f / (rowsq[row] * (1.0f / 1024.0f) + EPS);
                float* rp = out + (size_t)row * DM + col0;
#pragma unroll
                for (int bj = 0; bj < 2; ++bj)
#pragma unroll
                    for (int n = 0; n < 2; ++n) { const f32x4 h = *(const f32x4*)(rp + bj * 128 + n * 4); *(f32x4*)(rp + bj * 128 + n * 4) = h + acc[ai][bj][m][n] * r2; }
            }
    }
};
#define RAW_BAR() do { asm volatile("s_waitcnt lgkmcnt(0)" ::: "memory"); __builtin_amdgcn_s_barrier(); asm volatile("" ::: "memory"); } while (0)
DI int qkv_rowmap(int f) {
    if (f >= 1536) return f;
    const int fl = f & 255, wc = fl >> 6, bj = (fl >> 5) & 1, x = fl & 31;
    return (f & ~255) + 128 * bj + 32 * wc + x;
}
DI void p0_wtile(const float* W, const float* g0, const float* g1, int K, int N, bf16_t* out, bool perm, int tile, LAS float* tl, int tid) {
    const int ntn = N / 256, kt = tile / ntn, nt = tile % ntn, k0 = kt * 64, n0 = nt * 256;
    float v[32];
#pragma unroll
    for (int i = 0; i < 32; ++i) { const int kk = k0 + i * 2 + (tid >> 8); v[i] = W[(size_t)kk * N + n0 + (tid & 255)]; }
#pragma unroll
    for (int i = 0; i < 32; ++i) { const int k = i * 2 + (tid >> 8), kk = k0 + k;
        float gv = 1.f; if (g0) gv = (g1 && kk >= 512) ? g1[kk - 512] : g0[kk];
        tl[(tid & 255) * 65 + k] = v[i] * gv; }
    __syncthreads();
    { const int n = tid >> 1, half = tid & 1; const int r = perm ? qkv_rowmap(n0 + n) : (n0 + n);
      bf16_t* op = out + (size_t)r * K + k0 + 32 * half; const LAS float* tp = tl + n * 65 + 32 * half;
#pragma unroll
      for (int q = 0; q < 4; ++q) { u32x4 w; w.x = pk2(tp[8 * q], tp[8 * q + 1]); w.y = pk2(tp[8 * q + 2], tp[8 * q + 3]); w.z = pk2(tp[8 * q + 4], tp[8 * q + 5]); w.w = pk2(tp[8 * q + 6], tp[8 * q + 7]); *(u32x4*)(op + 8 * q) = w; } }
    RAW_BAR();
}
DI void p0_filter(const Params& p, int item, LAS float* sm, int tid) {
    const int tg = item >> 1, n = item & 1;
    LAS float* feat = sm;
    LAS float* h1 = sm + 8 * 34;
    LAS float* h2 = h1 + 8 * 64;
    if (tid < 8 * 33) { const int tt = tid / 33, e = tid % 33; const int t = tg * 8 + tt; float v;
        if (e == 0) v = (float)t / 2047.0f;
        else { const int i = (e - 1) & 15; const double fr = (double)(1e-4f) + (double)i * ((15.0 - 1e-4) / 15.0); double rev = (double)t * fr / 2048.0; rev -= floor(rev);
            float s, c; sincosf((float)(rev * 6.283185307179586), &s, &c); v = (e <= 16) ? c : -s; }
        feat[tt * 34 + e] = v; }
    __syncthreads();
    { const int tt = tid >> 6, k = tid & 63; float a = p.flt_b1[k];
#pragma unroll 11
      for (int e = 0; e < 33; ++e) a += feat[tt * 34 + e] * p.flt_w1[e * 64 + k];
      h1[tt * 64 + k] = sinf(p.flt_freq1[k] * a); }
    __syncthreads();
    { const int tt = tid >> 6, k = tid & 63; float a = p.flt_b2[k];
#pragma unroll 16
      for (int j = 0; j < 64; ++j) a += h1[tt * 64 + j] * p.flt_w2[j * 64 + k];
      h2[k * 8 + tt] = sinf(p.flt_freq2[k] * a); }
    __syncthreads();
    const int c = tid;
    float af[8], ab[8];
    { const float bf_ = p.flt_b3[(2 * n) * 512 + c], bb_ = p.flt_b3[(2 * n + 1) * 512 + c];
#pragma unroll
      for (int tt = 0; tt < 8; ++tt) { af[tt] = bf_; ab[tt] = bb_; } }
#pragma unroll 8
    for (int k = 0; k < 64; ++k) {
        const float wf = p.flt_w3[(size_t)k * 2048 + (2 * n) * 512 + c], wb = p.flt_w3[(size_t)k * 2048 + (2 * n + 1) * 512 + c];
        const f32x4 ha = *(const LAS f32x4*)(h2 + k * 8), hb = *(const LAS f32x4*)(h2 + k * 8 + 4);
#pragma unroll
        for (int tt = 0; tt < 4; ++tt) { af[tt] += ha[tt] * wf; ab[tt] += ha[tt] * wb; af[tt + 4] += hb[tt] * wf; ab[tt + 4] += hb[tt] * wb; }
    }
    const float dl = fabsf(-15.350567286626973f + (float)c * ((-3.0701134573253945f + 15.350567286626973f) / 511.0f));
    bf16_t* R = (bf16_t*)(p.ws + WS_R) + ((size_t)n * 512 + c) * 4096;
#pragma unroll
    for (int tt = 0; tt < 8; ++tt) { const int t = tg * 8 + tt; const float dec = expf(-((float)t / 2047.0f) * dl); af[tt] *= dec; ab[tt] *= dec; }
    if (tg == 0) { ab[0] += af[0]; R[0] = 0; }
    u32x4 w; w.x = pk2(ab[0], ab[1]); w.y = pk2(ab[2], ab[3]); w.z = pk2(ab[4], ab[5]); w.w = pk2(ab[6], ab[7]);
    *(u32x4*)(R + 2048 + tg * 8) = w;
#pragma unroll
    for (int tt = 0; tt < 8; ++tt) { const int t = tg * 8 + tt; if (t > 0) R[2048 - t] = (bf16_t)(pk2(af[tt], 0.f) & 0xffffu); }
    __syncthreads();
}
constexpr int P0_NW = 192 + 64 + 256 + 256, P0_NF = 512, P0_NR = 128, P0_NX = NTOK / 32;
DI void p0_prep(const Params& p, LAS unsigned char* lds, int G, int bid) {
    const int tid = threadIdx.x, lane = tid & 63, wave = tid >> 6;
    LAS float* sm = (LAS float*)lds;
    const int total = P0_NF + P0_NW + P0_NR + P0_NX;
    const int nper = (total + G - 1) / G, shift = (bid & 1) ? nper / 2 : 0;
    for (int kk = 0; kk < nper; ++kk) {
        int kq = kk + shift; if (kq >= nper) kq -= nper;
        const int it = bid + kq * G; if (it >= total) continue;
        int i = it;
        if (i < P0_NF) { p0_filter(p, i, sm, tid); continue; }
        i -= P0_NF;
        if (i < P0_NW) {
            if (i < 192) p0_wtile(p.w_in, p.mix_norm, nullptr, 1024, 3072, (bf16_t*)(p.ws + WS_WIN), true, i, sm, tid);
            else if (i < 256) p0_wtile(p.w_out, p.attn_out_norm, p.hy_out_norm, 1024, 1024, (bf16_t*)(p.ws + WS_WOUT), false, i - 192, sm, tid);
            else if (i < 512) p0_wtile(p.w_up, p.ffn_norm, nullptr, 1024, 4096, (bf16_t*)(p.ws + WS_WUP), false, i - 256, sm, tid);
            else p0_wtile(p.w_down, nullptr, nullptr, 4096, 1024, (bf16_t*)(p.ws + WS_WDN), false, i - 512, sm, tid);
            continue; }
        i -= P0_NW;
        if (i < P0_NR) { const int id = i * 512 + tid, s = id >> 5, fi = id & 31;
            const float inv = powf(10000.0f, -(float)fi / 32.0f); const float ang = (float)s * inv; float sn, cs_; sincosf(ang, &sn, &cs_);
            ((f32x2*)(p.ws + WS_CS))[id] = (f32x2){cs_, sn}; continue; }
        i -= P0_NR;
        { const int row0 = (i * 8 + wave) * 4;
          f32x4 v[4][4];
#pragma unroll
          for (int r = 0; r < 4; ++r) { const float* src = xrow(p, row0 + r);
#pragma unroll
              for (int q = 0; q < 2; ++q) { v[r][2 * q] = *(const f32x4*)(src + q * 512 + lane * 8); v[r][2 * q + 1] = *(const f32x4*)(src + q * 512 + lane * 8 + 4); } }
#pragma unroll
          for (int r = 0; r < 4; ++r) { bf16_t* dst = (bf16_t*)(p.ws + WS_XB) + (size_t)(row0 + r) * DM; float ss = 0.f;
#pragma unroll
              for (int q = 0; q < 2; ++q) { const f32x4 x = v[r][2 * q], y = v[r][2 * q + 1];
                  ss += (x[0] * x[0] + x[1] * x[1]) + (x[2] * x[2] + x[3] * x[3]) + (y[0] * y[0] + y[1] * y[1]) + (y[2] * y[2] + y[3] * y[3]);
                  u32x4 w; w.x = pk2(x[0], x[1]); w.y = pk2(x[2], x[3]); w.z = pk2(y[0], y[1]); w.w = pk2(y[2], y[3]); *(u32x4*)(dst + q * 512 + lane * 8) = w; }
              ss = wave_sum(ss);
              if (lane == 0) { ((float*)(p.ws + WS_RSTD1))[row0 + r] = __builtin_amdgcn_rsqf(ss * (1.0f / 1024.0f) + EPS); ((float*)(p.ws + WS_ROWSQ))[row0 + r] = 0.f; } } }
    }
}

typedef short s16x4 __attribute__((ext_vector_type(4)));
constexpr int AT_KSTR = 144, AT_ROWS = 448, AT_KOFF = 0, AT_VOFF = AT_ROWS * AT_KSTR, AT_OST = 2 * AT_VOFF;
static_assert(AT_OST + 8 * 32 * 128 <= LDS_BAR_OFF, "attention LDS map");
constexpr int AT_ITEMS = NBATCH * 8 * 24;
struct AtItem { int b, h, br, sh, L, cls, blk; };
DI AtItem at_decode(int item) { AtItem a; const int bh = item / 24, sub = item % 24; a.b = bh >> 3; a.h = bh & 7; a.br = sub >> 3; const int s = sub & 7;
    a.sh = 2 * a.br; a.L = SEQ >> a.sh; a.cls = a.br == 0 ? 0 : (a.br == 1 ? (s >> 1) : 2 * s); a.blk = a.br == 0 ? s : (a.br == 1 ? (s & 1) : 0); return a; }
DI size_t at_row_off(const AtItem& a, int j) { int cls = a.cls, i;
    if (a.br == 2) { const int hi = j >= 192 ? 1 : 0; cls += hi; i = j - 192 * hi - 64; } else i = 256 * a.blk - 64 + j;
    i = i < 0 ? 0 : (i >= a.L ? a.L - 1 : i);
    return (size_t)(cls + (i << a.sh)) * 64; }
#define AT_LOAD(itm) do { const AtItem a_ = at_decode(itm); \
    const bf16_t* kb_ = (const bf16_t*)(p.ws + WS_K) + (size_t)(a_.b * 8 + a_.h) * SEQ * 64 + (tid & 7) * 8; const bf16_t* vb_ = (const bf16_t*)(p.ws + WS_V) + (size_t)(a_.b * 8 + a_.h) * SEQ * 64 + (tid & 7) * 8; \
    _Pragma("unroll") for (int i_ = 0; i_ < 6; ++i_) { const size_t off_ = at_row_off(a_, (i_ * 512 + tid) >> 3); kv[i_] = *(const u32x4*)(kb_ + off_); vv[i_] = *(const u32x4*)(vb_ + off_); } \
    { const int qcls_ = a_.cls + (a_.br == 2 ? (w >> 2) : 0), qi0_ = (a_.br == 2 ? 32 * (w & 3) : 256 * a_.blk + 32 * w) + n; \
      const bf16_t* qp_ = (const bf16_t*)(p.ws + WS_Q) + ((size_t)(a_.b * 8 + a_.h) * SEQ + qcls_ + (qi0_ << a_.sh)) * 64 + 8 * kg; const size_t qs_ = (size_t)(16 << a_.sh) * 64; \
      qn[0] = *(const bf16x8*)(qp_); qn[1] = *(const bf16x8*)(qp_ + 32); qn[2] = *(const bf16x8*)(qp_ + qs_); qn[3] = *(const bf16x8*)(qp_ + qs_ + 32); } } while (0)
DI int at_map(int k, int G) { if (G & 7) return k; const int x = k & 7, kk = k >> 3; return (x + 8 * (kk / 24)) * 24 + kk % 24; }
DI void attn_phase(const Params& p, LAS unsigned char* lds, int G, int bid, float Mb) {
    int tid_ = threadIdx.x; asm volatile("" : "+v"(tid_));
    const int tid = tid_, lane = tid & 63, w = __builtin_amdgcn_readfirstlane(tid >> 6), n = lane & 15, kg = lane >> 4;
    LAS unsigned char* Ks = lds + AT_KOFF; LAS unsigned char* Vs = lds + AT_VOFF;
    for (int i = tid; i < 64 * AT_KSTR / 16; i += 512) { *(LAS u32x4*)(Ks + 384 * AT_KSTR + i * 16) = (u32x4){0u, 0u, 0u, 0u}; *(LAS u32x4*)(Vs + 384 * AT_KSTR + i * 16) = (u32x4){0u, 0u, 0u, 0u}; }
    int itk = bid; if (itk >= AT_ITEMS) return;
    int it = at_map(itk, G);
    u32x4 kv[6], vv[6]; bf16x8 qn[4];
    AT_LOAD(it);
    const bf16x8 ones = {(short)0x3f80, (short)0x3f80, (short)0x3f80, (short)0x3f80, (short)0x3f80, (short)0x3f80, (short)0x3f80, (short)0x3f80};
    for (;;) {
#pragma unroll
        for (int i = 0; i < 6; ++i) { const int j = (i * 512 + tid) >> 3; *(LAS u32x4*)(Ks + j * AT_KSTR + (tid & 7) * 16) = kv[i]; *(LAS u32x4*)(Vs + j * AT_KSTR + (tid & 7) * 16) = vv[i]; }
        const bf16x8 qa0 = qn[0], qa1 = qn[1], qb0 = qn[2], qb1 = qn[3];
        const AtItem a = at_decode(it);
        RAW_BAR();
        const int nitk = itk + G; const int nit = nitk < AT_ITEMS ? at_map(nitk, G) : AT_ITEMS;
        if (nit < AT_ITEMS) AT_LOAD(nit);
        const int w3 = w & 3, d16 = a.br == 2 ? 1 : 0;
        const int rowbase = d16 ? 192 * (w >> 2) + 32 * w3 : 32 * w;
        const int wlo = d16 ? -64 + 32 * w3 : 256 * a.blk - 64 + 32 * w;
        const bool edge = wlo < 0 || wlo + 160 > a.L;
        u32x2 pa[10], pb[10];
        pa[9] = (u32x2){0u, 0u}; pb[0] = (u32x2){0u, 0u};
        const LAS unsigned char* kr = Ks + (rowbase + n) * AT_KSTR + kg * 16;
#define AT_SPHASE(EDGE_) do { \
_Pragma("unroll") \
        for (int kt = 0; kt < 10; ++kt) { \
            const bf16x8 k0 = *(const LAS bf16x8*)(kr + kt * 16 * AT_KSTR), k1 = *(const LAS bf16x8*)(kr + kt * 16 * AT_KSTR + 64); \
            bool okr[4]; \
_Pragma("unroll") \
            for (int jj = 0; jj < 4; ++jj) okr[jj] = !(EDGE_) || ((unsigned)(wlo + 16 * kt + 4 * kg + jj) < (unsigned)a.L); \
            if (kt <= 8) { \
                f32x4 s = {-Mb, -Mb, -Mb, -Mb}; \
                s = __builtin_amdgcn_mfma_f32_16x16x32_bf16(k0, qa0, s, 0, 0, 0); s = __builtin_amdgcn_mfma_f32_16x16x32_bf16(k1, qa1, s, 0, 0, 0); \
_Pragma("unroll") \
                for (int jj = 0; jj < 4; ++jj) { float e = __builtin_amdgcn_exp2f(s[jj]); const int r0 = 4 * kg + jj; \
                    bool ok = okr[jj]; if (kt == 0) ok = ok && (r0 >= n); if (kt == 8) ok = ok && (r0 <= n); \
                    s[jj] = ok ? e : 0.f; } \
                pa[kt].x = pk2(s[0], s[1]); pa[kt].y = pk2(s[2], s[3]); \
            } \
            if (kt >= 1) { \
                f32x4 s = {-Mb, -Mb, -Mb, -Mb}; \
                s = __builtin_amdgcn_mfma_f32_16x16x32_bf16(k0, qb0, s, 0, 0, 0); s = __builtin_amdgcn_mfma_f32_16x16x32_bf16(k1, qb1, s, 0, 0, 0); \
_Pragma("unroll") \
                for (int jj = 0; jj < 4; ++jj) { float e = __builtin_amdgcn_exp2f(s[jj]); const int r0 = 4 * kg + jj; \
                    bool ok = okr[jj]; if (kt == 1) ok = ok && (r0 >= n); if (kt == 9) ok = ok && (r0 <= n); \
                    s[jj] = ok ? e : 0.f; } \
                pb[kt].x = pk2(s[0], s[1]); pb[kt].y = pk2(s[2], s[3]); \
            } \
        } \
        } while (0)
        if (edge) AT_SPHASE(true); else AT_SPHASE(false);
#undef AT_SPHASE
        f32x4 oa[4], ob[4], la = {0.f, 0.f, 0.f, 0.f}, lb2 = {0.f, 0.f, 0.f, 0.f};
#pragma unroll
        for (int mt = 0; mt < 4; ++mt) { oa[mt] = (f32x4){0.f, 0.f, 0.f, 0.f}; ob[mt] = (f32x4){0.f, 0.f, 0.f, 0.f}; }
        const LAS unsigned char* vr = Vs + (rowbase + 4 * kg + (n >> 2)) * AT_KSTR + (n & 3) * 8;
#pragma unroll
        for (int ks = 0; ks < 5; ++ks) {
            u32x4 bw; bw.x = pa[2 * ks].x; bw.y = pa[2 * ks].y; bw.z = pa[2 * ks + 1].x; bw.w = pa[2 * ks + 1].y;
            const bf16x8 fa = __builtin_bit_cast(bf16x8, bw);
            bw.x = pb[2 * ks].x; bw.y = pb[2 * ks].y; bw.z = pb[2 * ks + 1].x; bw.w = pb[2 * ks + 1].y;
            const bf16x8 fb = __builtin_bit_cast(bf16x8, bw);
            la = __builtin_amdgcn_mfma_f32_16x16x32_bf16(ones, fa, la, 0, 0, 0); lb2 = __builtin_amdgcn_mfma_f32_16x16x32_bf16(ones, fb, lb2, 0, 0, 0);
#pragma unroll
            for (int mt = 0; mt < 4; ++mt) {
                const s16x4 a0 = __builtin_amdgcn_ds_read_tr16_b64_v4i16((LAS s16x4*)(vr + ks * 32 * AT_KSTR + mt * 32));
                const s16x4 a1 = __builtin_amdgcn_ds_read_tr16_b64_v4i16((LAS s16x4*)(vr + ks * 32 * AT_KSTR + mt * 32 + 16 * AT_KSTR));
                bf16x8 af; af[0] = a0[0]; af[1] = a0[1]; af[2] = a0[2]; af[3] = a0[3]; af[4] = a1[0]; af[5] = a1[1]; af[6] = a1[2]; af[7] = a1[3];
                oa[mt] = __builtin_amdgcn_mfma_f32_16x16x32_bf16(af, fa, oa[mt], 0, 0, 0);
                ob[mt] = __builtin_amdgcn_mfma_f32_16x16x32_bf16(af, fb, ob[mt], 0, 0, 0);
            }
        }
        {
          LAS unsigned char* st = lds + AT_OST + w * (32 * 128);
#pragma unroll
          for (int mt = 0; mt < 4; ++mt) { const int ch = (2 * mt + (kg >> 1)), sub = (kg & 1) * 8;
              u32x2 wv; wv.x = pk2(oa[mt][0], oa[mt][1]); wv.y = pk2(oa[mt][2], oa[mt][3]); *(LAS u32x2*)(st + n * 128 + ((ch ^ (n & 7)) << 4) + sub) = wv;
              wv.x = pk2(ob[mt][0], ob[mt][1]); wv.y = pk2(ob[mt][2], ob[mt][3]); *(LAS u32x2*)(st + (16 + n) * 128 + ((ch ^ (n & 7)) << 4) + sub) = wv; }
          const int qcls = a.cls + (d16 ? (w >> 2) : 0), qi0 = d16 ? 32 * w3 : 256 * a.blk + 32 * w;
          bf16_t* obase = (bf16_t*)((unsigned char*)p.out + OUT_OACC) + (size_t)a.br * NTOK * 512 + ((size_t)(a.b * 8 + a.h) * SEQ + qcls) * 64;
          asm volatile("s_waitcnt lgkmcnt(0)" ::: "memory");
#pragma unroll
          for (int ps = 0; ps < 4; ++ps) { const int r = ps * 8 + (lane >> 3), chn = lane & 7;
              const u32x4 v = *(const LAS u32x4*)(st + r * 128 + ((chn ^ (r & 7)) << 4));
              *(u32x4*)(obase + (size_t)((qi0 + r) << a.sh) * 64 + chn * 8) = v; }
          if (kg == 0) { float* lp = (float*)(p.ws + WS_L) + ((size_t)a.br * NTOK + (size_t)a.b * SEQ + qcls) * 8 + a.h;
              lp[(size_t)((qi0 + n) << a.sh) * 8] = la[0]; lp[(size_t)((qi0 + 16 + n) << a.sh) * 8] = lb2[0]; } }
        RAW_BAR();
        if (nit >= AT_ITEMS) break;
        it = nit; itk = nitk;
    }
}
#undef AT_LOAD

constexpr int HY_ZSTR = 4112, HY_C0 = 16 * HY_ZSTR, HY_C1 = HY_C0 + 8208, HY_GS = HY_C1 + 8208, HY_ITEMS = 512 * 3;
static_assert(HY_GS + 16 * HY_ZSTR <= LDS_BAR_OFF, "hyena LDS map");
DI void hy_load_filter(const Params& p, LAS unsigned char* lds, int order, int c, int tid) {
    const bf16_t* R = (const bf16_t*)(p.ws + WS_R) + ((size_t)order * 512 + c) * 4096;
    const u32x4 a = *(const u32x4*)(R + 8 * tid);
    const unsigned nx = (tid < 511) ? (unsigned)R[8 * tid + 8] : 0u;
    *(LAS u32x4*)(lds + HY_C0 + tid * 16) = a;
    u32x4 s; s.x = (a.x >> 16) | (a.y << 16); s.y = (a.y >> 16) | (a.z << 16); s.z = (a.z >> 16) | (a.w << 16); s.w = (a.w >> 16) | (nx << 16);
    *(LAS u32x4*)(lds + HY_C1 + tid * 16) = s;
}
DI void hy_dma_rows(const Params& p, LAS unsigned char* lds, int f, int bg, int w, int lane) {
    const bf16_t* ut = (const bf16_t*)(p.ws + WS_UT) + (size_t)f * NTOK;
#pragma unroll
    for (int i = 0; i < 8; ++i) { const int seg = w * 8 + i, rn = seg >> 2, q = seg & 3, bb = 16 * bg + rn;
        if (bb < NBATCH) __builtin_amdgcn_global_load_lds((const unsigned*)(ut + (size_t)bb * SEQ + q * 512 + lane * 8), (LAS unsigned*)(lds + HY_GS + rn * HY_ZSTR + q * 1024), 16, 0, 0); }
}
#ifndef HY_NMI
#define HY_NMI 16
#endif
#define HY_NP (16 / HY_NMI)
DI void hyena_item(const Params& p, LAS unsigned char* lds, int item) {
    int tid_ = threadIdx.x; asm volatile("" : "+v"(tid_));
    const int tid = tid_, lane = tid & 63, w = __builtin_amdgcn_readfirstlane(tid >> 6), n = lane & 15, kg = lane >> 4;
    const int c = item / 3, bg = item % 3;
    hy_dma_rows(p, lds, c, bg, w, lane);
    hy_load_filter(p, lds, 0, c, tid);
    asm volatile("s_waitcnt vmcnt(0)" ::: "memory");
    __syncthreads();
    { const float w0 = p.hy_conv_w[c], w1 = p.hy_conv_w[1536 + c], w2 = p.hy_conv_w[3072 + c], cb = p.hy_conv_b[c];
#pragma unroll 2
      for (int it = 0; it < 8; ++it) { const int id = it * 512 + tid, zn = id >> 8, t8 = (id & 255) * 8, bb = 16 * bg + zn;
          u32x4 o = {0u, 0u, 0u, 0u};
          if (bb < NBATCH) { const LAS unsigned char* gp = lds + HY_GS + zn * HY_ZSTR + t8 * 2;
              const u32x4 d = *(const LAS u32x4*)gp; unsigned pm = *(const LAS unsigned*)(gp - 4), nx = *(const LAS unsigned*)(gp + 16);
              pm = t8 > 0 ? pm : 0u; nx = (t8 + 8 < SEQ) ? nx : 0u;
              float u[10]; u[0] = bf_hi(pm); u[9] = bf_lo(nx);
#pragma unroll
              for (int e = 0; e < 4; ++e) { u[1 + 2 * e] = bf_lo(d[e]); u[2 + 2 * e] = bf_hi(d[e]); }
              float r[8];
#pragma unroll
              for (int e = 0; e < 8; ++e) r[e] = cb + w0 * u[e] + w1 * u[e + 1] + w2 * u[e + 2];
              o.x = pk2(r[0], r[1]); o.y = pk2(r[2], r[3]); o.z = pk2(r[4], r[5]); o.w = pk2(r[6], r[7]); }
          *(LAS u32x4*)(lds + zn * HY_ZSTR + t8 * 2) = o; } }
    __syncthreads();
    const unsigned abase = ((n & 1) ? (unsigned)(HY_C1 - 2) : (unsigned)HY_C0) + 2u * (unsigned)(2048 - n + 8 * kg);
    const int b = 16 * bg + n;
#define HY_FRAG(e) ({ const LAS unsigned* fp_ = (const LAS unsigned*)(lds + (abase - 32 * (e))); u32x4 f_; f_.x = fp_[0]; f_.y = fp_[1]; f_.z = fp_[2]; f_.w = fp_[3]; __builtin_bit_cast(bf16x8, f_); })
#pragma unroll 1
    for (int order = 0; order < 2; ++order) {
        const int fg = 512 * (order + 1) + c;
        hy_dma_rows(p, lds, fg, bg, w, lane);
        const float skip = p.hy_skip[order * 512 + c];
        const float w0 = p.hy_conv_w[fg], w1 = p.hy_conv_w[1536 + fg], w2 = p.hy_conv_w[3072 + fg], cb = p.hy_conv_b[fg];
        bf16_t* dst = (bf16_t*)((unsigned char*)p.out + OUT_HYT) + ((size_t)(b < NBATCH ? b : 0) * 32 * 512 + c) * 64;
        u32x2 held[HY_NMI];
        const LAS unsigned char* zrow = lds + n * HY_ZSTR + kg * 16;
#pragma unroll
        for (int pass = 0; pass < HY_NP; ++pass) {
            f32x4 acc[HY_NMI]; bf16x8 ring[HY_NMI];
            const int E = 8 * HY_NMI * pass + HY_NMI * w;
#pragma unroll
            for (int mi = 0; mi < HY_NMI; ++mi) { acc[mi] = (f32x4){0.f, 0.f, 0.f, 0.f}; ring[mi] = HY_FRAG(E + mi); }
            bf16x8 bcur = *(const LAS bf16x8*)(zrow);
#pragma unroll 1
            for (int kb = 0; kb < 128 / HY_NMI; ++kb) {
#pragma unroll
                for (int kk = 0; kk < HY_NMI / 2; ++kk) {
                    const int ks = kb * (HY_NMI / 2) + kk;
                    const int kn = ks < 63 ? ks + 1 : 63;
                    const bf16x8 bnext = *(const LAS bf16x8*)(zrow + kn * 64);
                    acc[HY_NMI - 2] = __builtin_amdgcn_mfma_f32_16x16x32_bf16(ring[(HY_NMI - 2 - 2 * kk) & (HY_NMI - 1)], bcur, acc[HY_NMI - 2], 0, 0, 0);
                    acc[HY_NMI - 1] = __builtin_amdgcn_mfma_f32_16x16x32_bf16(ring[(HY_NMI - 1 - 2 * kk) & (HY_NMI - 1)], bcur, acc[HY_NMI - 1], 0, 0, 0);
                    asm volatile("" : "+v"(acc[HY_NMI - 2]), "+v"(acc[HY_NMI - 1]));
                    ring[(-2 * kk - 2) & (HY_NMI - 1)] = HY_FRAG(E - 2 * kn); ring[(-2 * kk - 1) & (HY_NMI - 1)] = HY_FRAG(E - 2 * kn + 1);
#pragma unroll
                    for (int mi = 2; mi < HY_NMI - 2; ++mi) acc[mi] = __builtin_amdgcn_mfma_f32_16x16x32_bf16(ring[(mi - 2 * kk) & (HY_NMI - 1)], bcur, acc[mi], 0, 0, 0);
                    acc[0] = __builtin_amdgcn_mfma_f32_16x16x32_bf16(ring[(0 - 2 * kk) & (HY_NMI - 1)], bcur, acc[0], 0, 0, 0);
                    acc[1] = __builtin_amdgcn_mfma_f32_16x16x32_bf16(ring[(1 - 2 * kk) & (HY_NMI - 1)], bcur, acc[1], 0, 0, 0);
                    bcur = bnext;
                }
            }
            if (pass == 0) { asm volatile("s_waitcnt vmcnt(0)" ::: "memory"); __syncthreads(); }
            u32x2 res[HY_NMI];
#pragma unroll
            for (int mi = 0; mi < HY_NMI; ++mi) {
                const int t = 128 * HY_NMI * pass + 16 * HY_NMI * w + 16 * mi + 4 * kg;
                const u32x2 zz = *(const LAS u32x2*)(lds + n * HY_ZSTR + t * 2);
                const LAS unsigned char* gp = lds + HY_GS + n * HY_ZSTR + t * 2;
                const u32x2 d = *(const LAS u32x2*)gp; unsigned pm = *(const LAS unsigned*)(gp - 4), nx = *(const LAS unsigned*)(gp + 8);
                pm = t > 0 ? pm : 0u; nx = (t + 4 < SEQ) ? nx : 0u;
                const float um = bf_hi(pm), up = bf_lo(nx), u0 = bf_lo(d.x), u1 = bf_hi(d.x), u2 = bf_lo(d.y), u3 = bf_hi(d.y);
                float g0 = cb + w0 * um + w1 * u0 + w2 * u1, g1 = cb + w0 * u0 + w1 * u1 + w2 * u2, g2 = cb + w0 * u1 + w1 * u2 + w2 * u3, g3 = cb + w0 * u2 + w1 * u3 + w2 * up;
                const float gm = (b < NBATCH) ? 1.f : 0.f;
                res[mi].x = pk2(gm * g0 * (acc[mi][0] + skip * bf_lo(zz.x)), gm * g1 * (acc[mi][1] + skip * bf_hi(zz.x)));
                res[mi].y = pk2(gm * g2 * (acc[mi][2] + skip * bf_lo(zz.y)), gm * g3 * (acc[mi][3] + skip * bf_hi(zz.y)));
            }
            if (order == 1 && b < NBATCH) {
#pragma unroll
                for (int mi = 0; mi < HY_NMI; ++mi) { const int t = 128 * HY_NMI * pass + 16 * HY_NMI * w + 16 * mi + 4 * kg; *(u32x2*)(dst + (size_t)(t >> 6) * (512 * 64) + (t & 63)) = res[mi]; }
            }
            if (pass + 1 < HY_NP) {
#pragma unroll
                for (int mi = 0; mi < HY_NMI; ++mi) held[mi] = res[mi];
            } else if (order == 0) {
                __syncthreads();
#pragma unroll
                for (int mi = 0; mi < HY_NMI; ++mi) { const int t0 = 16 * HY_NMI * w + 16 * mi + 4 * kg;
                    if (HY_NP == 2) *(LAS u32x2*)(lds + n * HY_ZSTR + t0 * 2) = held[mi];
                    *(LAS u32x2*)(lds + n * HY_ZSTR + (128 * HY_NMI * (HY_NP - 1) + t0) * 2) = res[mi]; }
                hy_load_filter(p, lds, 1, c, tid);
                __syncthreads();
            }
        }
    }
#undef HY_FRAG
    __syncthreads();
}

constexpr int MX_STR = 144, MX_T2 = 512 * MX_STR, MX_STR2 = 1032, MX_SST = MX_T2 + 64 * MX_STR2, MX_ITEMS = NTOK / 64;
static_assert(MX_SST % 16 == 0 && MX_SST + 64 * 8 * 4 <= LDS_BAR_OFF, "mix LDS map");
DI void mix_item(const Params& p, LAS unsigned char* lds, int item) {
    const int tid = threadIdx.x, lane = tid & 63, w = __builtin_amdgcn_readfirstlane(tid >> 6);
    const int tok0 = item * 64;
    const bf16_t* hyt = (const bf16_t*)((const unsigned char*)p.out + OUT_HYT);
    u32x4 hv[8];
#pragma unroll
    for (int it = 0; it < 8; ++it) { const int id = it * 512 + tid; hv[it] = *(const u32x4*)(hyt + ((size_t)item * 512 + (id >> 3)) * 64 + (id & 7) * 8); }
    bf16_t* mixed = (bf16_t*)(p.ws + WS_XB);
    const bf16_t* oacc = (const bf16_t*)((const unsigned char*)p.out + OUT_OACC);
    const float* lb = (const float*)(p.ws + WS_L);
    float av[8][8];
    { const size_t hoff = ((size_t)((tok0 >> 11) * 8 + w) * SEQ + (tok0 & (SEQ - 1))) * 64 + lane * 8;
      LAS float* sst = (LAS float*)(lds + MX_SST);
#pragma unroll
      for (int pb = 0; pb < 2; ++pb) {
          u32x4 d[4][3]; float lv[4][3];
#pragma unroll
          for (int q = 0; q < 4; ++q) { const int ps = 4 * pb + q;
#pragma unroll
              for (int br = 0; br < 3; ++br) { d[q][br] = *(const u32x4*)(oacc + (size_t)br * NTOK * 512 + hoff + ps * 512); lv[q][br] = lb[((size_t)br * NTOK + tok0 + 8 * ps + (lane >> 3)) * 8 + w]; } }
#pragma unroll
          for (int q = 0; q < 4; ++q) { const int ps = 4 * pb + q; const float il = 1.0f / (lv[q][0] + lv[q][1] + lv[q][2]); float ss = 0.f;
#pragma unroll
              for (int e2 = 0; e2 < 4; ++e2) { av[ps][2 * e2] = (bf_lo(d[q][0][e2]) + bf_lo(d[q][1][e2]) + bf_lo(d[q][2][e2])) * il; av[ps][2 * e2 + 1] = (bf_hi(d[q][0][e2]) + bf_hi(d[q][1][e2]) + bf_hi(d[q][2][e2])) * il; }
#pragma unroll
              for (int e2 = 0; e2 < 8; ++e2) ss += av[ps][e2] * av[ps][e2];
              ss += __shfl_xor(ss, 1); ss += __shfl_xor(ss, 2); ss += __shfl_xor(ss, 4);
              if ((lane & 7) == 0) sst[(8 * ps + (lane >> 3)) * 8 + w] = ss; }
      } }
#pragma unroll
    for (int it = 0; it < 8; ++it) { const int id = it * 512 + tid; *(LAS u32x4*)(lds + (id >> 3) * MX_STR + (id & 7) * 16) = hv[it]; }
    RAW_BAR();
    { const LAS float* sst = (const LAS float*)(lds + MX_SST);
      bf16_t* mrow = mixed + (((size_t)(tok0 >> 8) * 16 + w) * 256 + (tok0 & 255)) * 64 + lane * 8;
#pragma unroll
      for (int ps = 0; ps < 8; ++ps) { const f32x4 s0 = *(const LAS f32x4*)(sst + (8 * ps + (lane >> 3)) * 8), s1 = *(const LAS f32x4*)(sst + (8 * ps + (lane >> 3)) * 8 + 4);
          const float tot = ((s0[0] + s0[1]) + (s0[2] + s0[3])) + ((s1[0] + s1[1]) + (s1[2] + s1[3]));
          const float rs = __builtin_amdgcn_rsqf(tot * (1.0f / 512.0f) + EPS);
          u32x4 o; o.x = pk2(av[ps][0] * rs, av[ps][1] * rs); o.y = pk2(av[ps][2] * rs, av[ps][3] * rs); o.z = pk2(av[ps][4] * rs, av[ps][5] * rs); o.w = pk2(av[ps][6] * rs, av[ps][7] * rs);
          *(u32x4*)(mrow + ps * 512) = o; } }
    { const int g = lane >> 4, l = lane & 15;
      const LAS unsigned char* rp = lds + (64 * w + (l >> 2)) * MX_STR + (16 * g + 4 * (l & 3)) * 2;
      LAS unsigned char* wp = lds + MX_T2 + lane * MX_STR2 + 64 * w * 2;
#pragma unroll
      for (int i = 0; i < 16; ++i) { const s16x4 v = __builtin_amdgcn_ds_read_tr16_b64_v4i16((LAS s16x4*)(rp + i * 4 * MX_STR)); *(LAS s16x4*)(wp + i * 8) = v; } }
    RAW_BAR();
#pragma unroll 4
    for (int tk = 0; tk < 8; ++tk) {
        const int tl = 8 * w + tk; const size_t tok = (size_t)tok0 + tl;
        const u32x2 d0 = *(const LAS u32x2*)(lds + MX_T2 + tl * MX_STR2 + lane * 16), d1 = *(const LAS u32x2*)(lds + MX_T2 + tl * MX_STR2 + lane * 16 + 8);
        float v[8]; v[0] = bf_lo(d0.x); v[1] = bf_hi(d0.x); v[2] = bf_lo(d0.y); v[3] = bf_hi(d0.y); v[4] = bf_lo(d1.x); v[5] = bf_hi(d1.x); v[6] = bf_lo(d1.y); v[7] = bf_hi(d1.y);
        float ss = 0.f;
#pragma unroll
        for (int e = 0; e < 8; ++e) ss += v[e] * v[e];
        ss = wave_sum(ss); const float rs = __builtin_amdgcn_rsqf(ss * (1.0f / 512.0f) + EPS);
        u32x4 o; o.x = pk2(v[0] * rs, v[1] * rs); o.y = pk2(v[2] * rs, v[3] * rs); o.z = pk2(v[4] * rs, v[5] * rs); o.w = pk2(v[6] * rs, v[7] * rs);
        *(u32x4*)(mixed + (((tok >> 8) * 16 + 8 + (lane >> 3)) * 256 + (tok & 255)) * 64 + (lane & 7) * 8) = o;
    }
    RAW_BAR();
}

#ifndef GEMM_SP2
#define GEMM_SP2 true
#endif
#ifndef GEMM_ALIGN
#define GEMM_ALIGN true
#endif
#ifndef REP_P0
#define REP_P0 1
#endif
#ifndef REP_P3
#define REP_P3 1
#endif
#ifndef REP_SYNC
#define REP_SYNC 1
#endif
#ifndef REP_HY
#define REP_HY 1
#endif
#ifndef REP_AT
#define REP_AT 1
#endif
#ifndef REP_UP
#define REP_UP 1
#endif
__global__ void __launch_bounds__(512, 2) fwd_kernel(Params p) {
    extern __shared__ __attribute__((aligned(16))) unsigned char lds_raw[];
    LAS unsigned char* lds = (LAS unsigned char*)lds_raw;
    const int G = gridDim.x, bid = blockIdx.x;
    const int lo = p.ph_lo, hi = p.ph_hi;
    cg::grid_group grid = cg::this_grid();
    if (hi > 1000) grid.sync();
    if (threadIdx.x < 4) ((LAS unsigned*)(lds + LDS_BAR_OFF))[threadIdx.x] = 0u;
    __syncthreads();
    XcdBarrier xbar; xbar.bar = (unsigned*)(p.ws + WS_BAR); xbar.x = 0; xbar.st = (volatile LAS unsigned*)(lds + LDS_BAR_OFF);
    if (hi - lo > 1) xbar = xcd_barrier_post((unsigned*)(p.ws + WS_BAR), (volatile LAS unsigned*)(lds + LDS_BAR_OFF));
#define IN(k) (lo <= (k) && (k) < hi)
#define SEAM(k) do { if (IN(k) && IN((k) + 1)) for (int rs_ = 0; rs_ < REP_SYNC; ++rs_) xcd_barrier(xbar); } while (0)
    bf16_t* xb = (bf16_t*)(p.ws + WS_XB);
    if (IN(0)) for (int rep = 0; rep < REP_P0; ++rep) p0_prep(p, lds, G, bid);
    SEAM(0);
    if (IN(1)) {
        { pg8::Gemm g{xb, (const bf16_t*)(p.ws + WS_WIN), NTOK, 1536, DM}; pg8::StaticOrder S; S.init(NTOK, 1536, G, bid);
          EpiQKV E{(bf16_t*)(p.ws + WS_Q), (const float*)(p.ws + WS_RSTD1), p.q_norm, p.k_norm, (const f32x2*)(p.ws + WS_CS)};
          pg8::gemm_phase<EpiQKV, pg8::StaticOrder, GEMM_ALIGN, GEMM_SP2>(lds, g, S, E); }
        { pg8::Gemm g{(const bf16_t*)(p.ws + WS_WIN) + (size_t)1536 * DM, xb, 1536, NTOK, DM}; pg8::StaticOrder S; S.init(1536, NTOK, G, (G % 16 == 0) ? (bid + G / 2) % G : bid);
          EpiUT E{(bf16_t*)(p.ws + WS_UT), (const float*)(p.ws + WS_RSTD1)};
          pg8::gemm_phase<EpiUT, pg8::StaticOrder, GEMM_ALIGN, GEMM_SP2>(lds, g, S, E); }
    }
    SEAM(1);
    if (IN(2)) {
#pragma unroll 1
        for (int ph = 0; ph < 2; ++ph) {
            if (ph == ((bid & 1) ? 0 : 1)) {
                int ln_ = threadIdx.x & 63; asm volatile("" : "+v"(ln_));
                float gq = fabsf(p.q_norm[ln_]), gk = fabsf(p.k_norm[ln_]);
#pragma unroll
                for (int s = 1; s < 64; s <<= 1) { gq = fmaxf(gq, __shfl_xor(gq, s)); gk = fmaxf(gk, __shfl_xor(gk, s)); }
                const float Mb = 8.0f * gq * gk * 1.4426950408889634f;
                for (int rep = 0; rep < REP_AT; ++rep) attn_phase(p, lds, G, bid, Mb);
            }
            if (ph == 0) { for (int rep = 0; rep < REP_HY; ++rep) for (int it = bid; it < HY_ITEMS; it += G) hyena_item(p, lds, it); }
        }
    }
    SEAM(2);
    if (IN(3)) { for (int rep = 0; rep < REP_P3; ++rep) for (int it = bid; it < MX_ITEMS; it += G) mix_item(p, lds, it); }
    SEAM(3);
    if (IN(4)) { pg8::Gemm g{xb, (const bf16_t*)(p.ws + WS_WOUT), NTOK, DM, DM}; pg8::StaticOrder S; S.init(NTOK, DM, G, bid);
        EpiH E{p.x_prompt, p.x_sample, p.out, (bf16_t*)(p.ws + WS_HB), (float*)(p.ws + WS_ROWSQ)};
        pg8::gemm_phase<EpiH, pg8::StaticOrder, GEMM_ALIGN, GEMM_SP2>(lds, g, S, E); }
    SEAM(4);
    if (IN(5)) for (int rep = 0; rep < REP_UP; ++rep) { pg8::Gemm g{(const bf16_t*)(p.ws + WS_HB), (const bf16_t*)(p.ws + WS_WUP), NTOK, DFF, DM}; pg8::StaticOrder S; S.init(NTOK, DFF, G, bid);
        EpiUp E{(bf16_t*)(p.ws + WS_A)};
        pg8::gemm_phase<EpiUp, pg8::StaticOrder, GEMM_ALIGN, GEMM_SP2>(lds, g, S, E); }
    SEAM(5);
    if (IN(6)) { pg8::Gemm g{(const bf16_t*)(p.ws + WS_A), (const bf16_t*)(p.ws + WS_WDN), NTOK, DM, DFF}; pg8::StaticOrder S; S.init(NTOK, DM, G, bid);
        EpiDown E{p.out, (const float*)(p.ws + WS_ROWSQ)};
        pg8::gemm_phase<EpiDown, pg8::StaticOrder, GEMM_ALIGN, GEMM_SP2>(lds, g, S, E); }
#undef IN
#undef SEAM
}

#ifndef N_LAUNCH_MODE
#define N_LAUNCH_MODE 1
#endif
extern "C" void kernel_launch(void* const* d_in, const int* in_sizes, int n_in, void* d_out, int out_size, void* d_ws, size_t ws_size, hipStream_t stream) {
    static int grid = 0;
    if (grid == 0) {
        if (n_in != 23 || ws_size < WS_TOTAL) { fprintf(stderr, "kernel_launch: unexpected n_in %d / ws %zu (need %zu)\n", n_in, ws_size, (size_t)WS_TOTAL); grid = -1; return; }
        int dev = 0, cus = 0, per_cu = 0;
        (void)hipGetDevice(&dev); (void)hipDeviceGetAttribute(&cus, hipDeviceAttributeMultiprocessorCount, dev);
        if (hipFuncSetAttribute((const void*)fwd_kernel, hipFuncAttributeMaxDynamicSharedMemorySize, LDS_BYTES) != hipSuccess) { fprintf(stderr, "kernel_launch: hipFuncSetAttribute failed\n"); grid = -1; return; }
        if (hipOccupancyMaxActiveBlocksPerMultiprocessor(&per_cu, (const void*)fwd_kernel, 512, LDS_BYTES) != hipSuccess || per_cu < 1) { fprintf(stderr, "kernel_launch: occupancy query gave %d\n", per_cu); per_cu = 1; }
        (void)hipGetLastError();
        grid = cus * per_cu;
    }
    if (grid < 0) return;
    Params p{};
    const float** pp = (const float**)&p;
    for (int i = 0; i < 23; ++i) pp[i] = (const float*)d_in[i];
    p.out = (float*)d_out; p.ws = (unsigned char*)d_ws;
#if N_LAUNCH_MODE == 1
    if (hipMemsetAsync((unsigned char*)d_ws + WS_BAR, 0, XCD_BAR_WORDS * 4, stream) != hipSuccess) { fprintf(stderr, "kernel_launch: memset of barrier words failed\n"); return; }
    p.ph_lo = 0; p.ph_hi = 7;
    void* args[] = {&p};
    hipError_t e = hipLaunchCooperativeKernel((const void*)fwd_kernel, dim3(grid), dim3(512), args, LDS_BYTES, stream);
    if (e != hipSuccess) fprintf(stderr, "cooperative launch failed: %s (grid %d)\n", hipGetErrorString(e), grid);
#else
    for (int k = 0; k < 7; ++k) { p.ph_lo = k; p.ph_hi = k + 1; fwd_kernel<<<dim3(grid), dim3(512), LDS_BYTES, stream>>>(p); }
#endif
}
```
